# Optimizing an MI355X kernel written in HIP

```python
import jax, jax.numpy as jnp
from jax import lax
import numpy as np

D_MODEL = 1024
BATCH = 8
SEQ = 4096
DEPTH = 2

HEAD_DIM = 128
N_MEM_TOK = 256
MEM_HEADS = 4
MEM_W = MEM_HEADS * HEAD_DIM
A_GROUPS = ((128, 1), (512, 4), (2048, 16))
N_A_GROUPS = len(A_GROUPS)
A_HEADS = 8
A_W = A_HEADS * HEAD_DIM
B_Q_HEADS = 8
B_KV_HEADS = 2
B_GROUP = B_Q_HEADS // B_KV_HEADS
B_W = B_Q_HEADS * HEAD_DIM
B_KV_W = B_KV_HEADS * HEAD_DIM
MIX_W = A_W
BRANCH_W = MIX_W + MEM_W
IN_A = 3 * N_A_GROUPS * A_W + MEM_W + BRANCH_W
IN_B = B_W + 2 * B_KV_W + MEM_W + BRANCH_W
ROPE_THETA = 500000.0
ROT_DIM_A = HEAD_DIM // 4
AXIAL_THETA = 10000.0
GRID_W = 64
Q_BLOCK = 128
EPS = 1e-6
N_A = (DEPTH + 1) // 2
N_B = DEPTH // 2

kernel_name = 'hybrid_dilated_axial_gqa_encoder'


def rmsnorm(x, g):
    xf = x.astype(jnp.float32)
    y = xf * lax.rsqrt(jnp.mean(xf * xf, axis=-1, keepdims=True) + EPS)
    return (y * g.astype(jnp.float32)).astype(x.dtype)


def rope_angles(pos, dim, theta):
    inv = theta ** (-jnp.arange(0, dim, 2, dtype=jnp.float32) / dim)
    return pos.astype(jnp.float32)[:, None] * inv[None, :]


def apply_rope(x, ang):
    half = ang.shape[-1]
    rd = 2 * half
    shape = (1, ang.shape[0]) + (1,) * (x.ndim - 3) + (half,)
    cos = jnp.cos(ang).reshape(shape)
    sin = jnp.sin(ang).reshape(shape)
    xf = x.astype(jnp.float32)
    x1 = xf[..., :half]
    x2 = xf[..., half:rd]
    out = jnp.concatenate([x1 * cos - x2 * sin, x2 * cos + x1 * sin, xf[..., rd:]], axis=-1)
    return out.astype(x.dtype)


def dilated_window_attention(q, k, v, window, dilation):
    Bn, S, H, E = q.shape
    r = window // (2 * dilation)
    L = S // dilation
    nb = -(-L // r)
    Lp = nb * r

    def sub(a):
        return a.reshape(Bn, L, dilation, H, E).transpose(0, 2, 1, 3, 4)

    qb = jnp.pad(sub(q), ((0, 0), (0, 0), (0, Lp - L), (0, 0), (0, 0))).reshape(Bn, dilation, nb, r, H, E)

    def key_blocks(a):
        ap = jnp.pad(sub(a), ((0, 0), (0, 0), (r, Lp - L + r), (0, 0), (0, 0)))
        ap = ap.reshape(Bn, dilation, nb + 2, r, H, E)
        return jnp.concatenate([ap[:, :, :-2], ap[:, :, 1:-1], ap[:, :, 2:]], axis=3)

    kb = key_blocks(k)
    vb = key_blocks(v)
    qi = jnp.arange(nb)[:, None, None] * r + jnp.arange(r)[None, :, None]
    kj = (jnp.arange(nb)[:, None, None] - 1) * r + jnp.arange(3 * r)[None, None, :]
    valid = (jnp.abs(qi - kj) <= r) & (kj >= 0) & (kj < L)
    s = jnp.einsum('bdnqhe,bdnkhe->bdnhqk', qb, kb).astype(jnp.float32)
    s = jnp.where(valid[None, None, :, None], s, -jnp.inf)
    m = jnp.max(s, axis=-1, keepdims=True)
    p = jnp.exp(s - m)
    den = jnp.sum(p, axis=-1, keepdims=True)
    o = jnp.einsum('bdnhqk,bdnkhe->bdnqhe', (p / den).astype(v.dtype), vb)
    lse = (m + jnp.log(den))[..., 0]
    o = o.reshape(Bn, dilation, Lp, H, E)[:, :, :L].transpose(0, 2, 1, 3, 4).reshape(Bn, S, H, E)
    lse = lse.transpose(0, 1, 2, 4, 3).reshape(Bn, dilation, Lp, H)[:, :, :L]
    lse = lse.transpose(0, 2, 1, 3).reshape(Bn, S, H)
    return o, lse


def mixer_dilated(qkv, qn_g, kn_g, ang):
    Bn, S, _ = qkv.shape
    qkv = qkv.reshape(Bn, S, 3, N_A_GROUPS, A_HEADS, HEAD_DIM)
    q = rmsnorm(qkv[:, :, 0], qn_g[:, None, :])
    k = rmsnorm(qkv[:, :, 1], kn_g[:, None, :])
    v = qkv[:, :, 2]
    q = apply_rope(q, ang) * (HEAD_DIM ** -0.5)
    k = apply_rope(k, ang)
    outs, lses = [], []
    for g, (window, dilation) in enumerate(A_GROUPS):
        o_g, l_g = dilated_window_attention(q[:, :, g], k[:, :, g], v[:, :, g], window, dilation)
        outs.append(o_g)
        lses.append(l_g)
    o = jnp.stack(outs, axis=2)
    w = jax.nn.softmax(jnp.stack(lses, axis=2), axis=2)
    o = jnp.sum(w[..., None].astype(o.dtype) * o, axis=2)
    return o.reshape(Bn, S, A_W)


def mixer_axial_gqa(q, k, v, qn_g, kn_g, ang):
    Bn, S, _ = q.shape
    q = rmsnorm(q.reshape(Bn, S, B_Q_HEADS, HEAD_DIM), qn_g)
    k = rmsnorm(k.reshape(Bn, S, B_KV_HEADS, HEAD_DIM), kn_g)
    v = v.reshape(Bn, S, B_KV_HEADS, HEAD_DIM)
    q = apply_rope(q, ang) * (HEAD_DIM ** -0.5)
    k = apply_rope(k, ang)
    n_qb = S // Q_BLOCK
    qb = q.reshape(Bn, n_qb, Q_BLOCK, B_KV_HEADS, B_GROUP, HEAD_DIM).transpose(1, 0, 2, 3, 4, 5)

    def block(qi):
        s = jnp.einsum('bqhge,bshe->bhgqs', qi, k).astype(jnp.float32)
        p = jax.nn.softmax(s, axis=-1).astype(v.dtype)
        return jnp.einsum('bhgqs,bshe->bqhge', p, v)

    o = lax.map(block, qb)
    return o.transpose(1, 0, 2, 3, 4, 5).reshape(Bn, S, B_W)


def memory_attention(q_mem, mem_h, w_kv, qn_g, kn_g):
    Bn, S, _ = q_mem.shape
    N = mem_h.shape[1]
    q = rmsnorm(q_mem.reshape(Bn, S, MEM_HEADS, HEAD_DIM), qn_g) * (HEAD_DIM ** -0.5)
    kv = jnp.einsum('bnd,de->bne', mem_h, w_kv).reshape(Bn, N, 2, MEM_HEADS, HEAD_DIM)
    k = rmsnorm(kv[:, :, 0], kn_g)
    v = kv[:, :, 1]
    s = jnp.einsum('bqhe,bkhe->bhqk', q, k).astype(jnp.float32)
    p = jax.nn.softmax(s, axis=-1).astype(v.dtype)
    return jnp.einsum('bhqk,bkhe->bqhe', p, v).reshape(Bn, S, MEM_W)


def setup_inputs(seed: int = 0) -> dict:
    key = jax.random.key(seed)
    ks = jax.random.split(key, 16)
    nrm = jax.random.normal
    f32 = jnp.float32
    return {
        'x': nrm(ks[0], (BATCH, SEQ, D_MODEL), f32),
        'mem': nrm(ks[1], (BATCH, N_MEM_TOK, D_MODEL), f32),
        'norm_g': 1.0 + 0.01 * nrm(ks[2], (DEPTH, D_MODEL), f32),
        'mem_norm_g': 1.0 + 0.01 * nrm(ks[3], (DEPTH, D_MODEL), f32),
        'w_mem_kv': nrm(ks[4], (DEPTH, D_MODEL, 2 * MEM_W), f32) * D_MODEL ** -0.5,
        'mem_qn_g': 1.0 + 0.01 * nrm(ks[5], (DEPTH, HEAD_DIM), f32),
        'mem_kn_g': 1.0 + 0.01 * nrm(ks[6], (DEPTH, HEAD_DIM), f32),
        'w_out': nrm(ks[7], (DEPTH, BRANCH_W, D_MODEL), f32) * BRANCH_W ** -0.5,
        'w_in_a': nrm(ks[8], (N_A, D_MODEL, IN_A), f32) * D_MODEL ** -0.5,
        'qn_a': 1.0 + 0.01 * nrm(ks[9], (N_A, N_A_GROUPS, HEAD_DIM), f32),
        'kn_a': 1.0 + 0.01 * nrm(ks[10], (N_A, N_A_GROUPS, HEAD_DIM), f32),
        'w_in_b': nrm(ks[11], (N_B, D_MODEL, IN_B), f32) * D_MODEL ** -0.5,
        'qn_b': 1.0 + 0.01 * nrm(ks[12], (N_B, HEAD_DIM), f32),
        'kn_b': 1.0 + 0.01 * nrm(ks[13], (N_B, HEAD_DIM), f32),
    }


def reference(x, mem, norm_g, mem_norm_g, w_mem_kv, mem_qn_g, mem_kn_g, w_out,
              w_in_a, qn_a, kn_a, w_in_b, qn_b, kn_b):
    S = x.shape[1]
    ROWS = S // GRID_W
    pos = jnp.arange(S, dtype=jnp.int32)
    row = jnp.repeat(jnp.arange(ROWS, dtype=jnp.int32), GRID_W)
    col = jnp.tile(jnp.arange(GRID_W, dtype=jnp.int32), ROWS)
    ang_a = rope_angles(pos, ROT_DIM_A, ROPE_THETA)
    ang_b = jnp.concatenate([rope_angles(row, HEAD_DIM // 2, AXIAL_THETA),
                             rope_angles(col, HEAD_DIM // 2, AXIAL_THETA)], axis=-1)
    for i in range(DEPTH):
        h = rmsnorm(x, norm_g[i])
        mem_h = rmsnorm(mem, mem_norm_g[i])
        j = i // 2
        if i % 2 == 0:
            proj = jnp.einsum('bsd,de->bse', h, w_in_a[j])
            n_qkv = 3 * N_A_GROUPS * A_W
            qkv = proj[..., :n_qkv]
            q_mem = proj[..., n_qkv:n_qkv + MEM_W]
            gate = proj[..., n_qkv + MEM_W:]
            o_mix = mixer_dilated(qkv, qn_a[j], kn_a[j], ang_a)
        else:
            proj = jnp.einsum('bsd,de->bse', h, w_in_b[j])
            c1 = B_W
            c2 = c1 + B_KV_W
            c3 = c2 + B_KV_W
            c4 = c3 + MEM_W
            o_mix = mixer_axial_gqa(proj[..., :c1], proj[..., c1:c2], proj[..., c2:c3],
                                    qn_b[j], kn_b[j], ang_b)
            q_mem = proj[..., c3:c4]
            gate = proj[..., c4:]
        o_mem = memory_attention(q_mem, mem_h, w_mem_kv[i], mem_qn_g[i], mem_kn_g[i])
        y = jnp.concatenate([o_mix, o_mem], axis=-1) * jax.nn.silu(gate)
        x = x + jnp.einsum('bse,ed->bsd', y, w_out[i])
    return x
```

```cpp
#include <hip/hip_runtime.h>
#include <hip/hip_cooperative_groups.h>
#include <cstdio>
#include <cstdint>
#include <cmath>
#include <cstddef>
namespace cg = cooperative_groups;

#define LAS __attribute__((address_space(3)))
typedef unsigned short bf16_t;
typedef short bf16x8 __attribute__((ext_vector_type(8)));
typedef short s16x4 __attribute__((ext_vector_type(4)));
typedef float f32x4 __attribute__((ext_vector_type(4)));
typedef float f32x2 __attribute__((ext_vector_type(2)));
typedef float f32x16 __attribute__((ext_vector_type(16)));
typedef unsigned u32x4 __attribute__((ext_vector_type(4)));

constexpr int BATCH = 8, SEQ = 4096, DM = 1024, NTOK = BATCH * SEQ;
constexpr int HD = 128, NMEM = 256;
constexpr int INA = 11264, INB = 3584, BRW = 1536;
constexpr int NCH = 2, CB = BATCH / NCH, CTOK = CB * SEQ;
constexpr float EPS = 1e-6f;
constexpr float SCALE = 0.088388347648318440f;

constexpr size_t MiB = 1u << 20;
constexpr size_t WS_WB = 0, WS_WO = 8 * MiB, WS_WM = 14 * MiB, WS_MKV = 18 * MiB, WS_TABA = 26 * MiB, WS_TABB = 27 * MiB, WS_SS1 = 29 * MiB, WS_LSE = 31 * MiB;
constexpr size_t WS_BAR = 33 * MiB;
constexpr size_t WS_Y = 34 * MiB, WS_R = 130 * MiB, WS_END = 482 * MiB;
constexpr size_t R_QKV = 0, R_GATE0 = 288 * MiB, R_QM0 = 336 * MiB;
constexpr size_t R_A1 = 0, R_Q1 = 64 * MiB, R_K1 = 128 * MiB, R_V1 = 144 * MiB, R_QM1 = 160 * MiB, R_GATE1 = 192 * MiB;
constexpr size_t WS_WA = 482 * MiB, WS_MEMA = 505 * MiB, WS_END2 = 509 * MiB;

__device__ __forceinline__ unsigned f2bf(float f) { unsigned u = __builtin_bit_cast(unsigned, f); return (u + 0x7fffu + ((u >> 16) & 1u)) >> 16; }
__device__ __forceinline__ unsigned pk2(float lo, float hi) { return f2bf(lo) | (f2bf(hi) << 16); }
__device__ __forceinline__ float bf2f(unsigned short b) { return __uint_as_float(((unsigned)b) << 16); }
__device__ __forceinline__ unsigned cvt_pk_bf16(float lo, float hi) { unsigned r; asm volatile("v_cvt_pk_bf16_f32 %0, %1, %2" : "=v"(r) : "v"(lo), "v"(hi)); return r; }
__device__ __forceinline__ int tid_now(int wave_s) { int l; asm volatile("v_mbcnt_lo_u32_b32 %0, -1, 0\n\tv_mbcnt_hi_u32_b32 %0, -1, %0" : "=v"(l)); l = (wave_s << 6) | l; __builtin_assume(l >= 0 && l < 512); return l; }
template <class T> __device__ __forceinline__ T* as_global(T* p) { return (T*)(__attribute__((address_space(1))) T*)p; }
__device__ __forceinline__ float shfl_xor_l(float v, int m, int lane) { return __int_as_float(__builtin_amdgcn_ds_bpermute((lane ^ m) << 2, __float_as_int(v))); }
__device__ __forceinline__ float silu(float g) { return g / (1.f + __expf(-g)); }

namespace pg8 {
constexpr int BM = 256, BK = 64, HALF = 128, HTB = HALF * BK * 2, STAGE_BYTES = 8 * HTB, NXCD = 8, WGM = 8;
__host__ __device__ __forceinline__ int lds_byte(int r, int c) { const int st = (r >> 4) * 2 + (c >> 5), rr = r & 15, cc = c & 31, ob = rr * 64 + cc * 2; return st * 1024 + (ob ^ (((ob >> 9) & 1) << 5)); }
__host__ __device__ __forceinline__ void stage_rc(int b, int& R, int& C) { const int st = b / 1024, sb = b % 1024, swz = sb ^ (((sb >> 9) & 1) << 5); R = (st >> 1) * 16 + swz / 64; C = (st & 1) * 32 + (swz % 64) / 2; }
__host__ __device__ __forceinline__ int perm32(int rho) { const int n = rho >> 4, i = rho & 15; return 8 * (i >> 2) + 4 * n + (i & 3); }
struct Unit { int pm, pn; };
struct Gemm { const bf16_t* A; const bf16_t* Bt; int M, N, K; };
struct StaticOrder {
    int nM, nN, nwg, G, c, wgm;
    __host__ __device__ void init(int M, int N, int G_, int c_, int wgm_ = WGM) { nM = M / BM; nN = N / BM; nwg = nM * nN; G = G_; c = c_; wgm = wgm_; }
    __host__ __device__ bool next(int i, Unit& u) const {
        const long L = (long)i * G + c; if (L >= nwg) return false;
        int wgid = (int)L; { const int q = nwg / NXCD, r = nwg % NXCD, xcd = wgid % NXCD, off = wgid / NXCD; wgid = (xcd < r ? xcd * (q + 1) : r * (q + 1) + (xcd - r) * q) + off; }
        const int nig = wgm * nN, gid = wgid / nig, fm = gid * wgm, gsz = (nM - fm) < wgm ? (nM - fm) : wgm;
        u.pm = fm + ((wgid % nig) % gsz); u.pn = (wgid % nig) / gsz; return true;
    }
};

template <class Epi>
__device__ __forceinline__ void gemm_phase(const int wave_s, LAS unsigned char* lds, const Gemm g, const StaticOrder& S, const Epi& E) {
    const int tid = tid_now(wave_s);
    int wid = wave_s; asm volatile("" : "+s"(wid));
    const int lane = tid & 63, wr = wid >> 2, wc = wid & 3, fr = lane & 15, fq = lane >> 4;
    const int K = g.K, nt = K / BK;
    unsigned voffA[2], voffB[2];
#pragma unroll
    for (int i = 0; i < 2; ++i) { int R, C; stage_rc(tid * 16 + i * 8192, R, C); const int Rb = (R & ~31) + perm32(R & 31);
        voffA[i] = (unsigned)(R * K + C) * 2u; voffB[i] = (unsigned)(Rb * K + C) * 2u; }
    const size_t kstep = (size_t)(BK * 2);
    const size_t hstep = (size_t)HALF * K * 2;
    const size_t tstep = 2 * hstep;
    const unsigned ldsw = (unsigned)wid * 1024u;
    const int aoff = lds_byte(wr * 64 + fr, fq * 8), boff = lds_byte(wc * 32 + fr, fq * 8);
#define PG8_SA(b, h) (((b) * 2 + (h)) * HTB)
#define PG8_SB(b, h) ((4 + (b) * 2 + (h)) * HTB)
#define PG8_STAGE(bufoff, gbase, voff) do { _Pragma("unroll") for (int _i = 0; _i < 2; ++_i) \
        __builtin_amdgcn_global_load_lds((const unsigned*)((const char*)(gbase) + (voff)[_i]), (LAS unsigned*)(lds + (bufoff) + ldsw + _i * 8192), 16, 0, 0); } while (0)
#define PG8_LDA(dst, b, h) do { _Pragma("unroll") for (int m = 0; m < 4; ++m) _Pragma("unroll") for (int k = 0; k < 2; ++k) dst[m][k] = *(const LAS bf16x8*)(lds + PG8_SA(b, h) + aoff + m * 2048 + k * 1024); } while (0)
#define PG8_LDB(dst, b, h) do { _Pragma("unroll") for (int n = 0; n < 2; ++n) _Pragma("unroll") for (int k = 0; k < 2; ++k) dst[n][k] = *(const LAS bf16x8*)(lds + PG8_SB(b, h) + boff + n * 2048 + k * 1024); } while (0)
#define PG8_MMA(ai, bj, At, Bt) do { __builtin_amdgcn_s_setprio(1); _Pragma("unroll") for (int m = 0; m < 4; ++m) _Pragma("unroll") for (int n = 0; n < 2; ++n) _Pragma("unroll") for (int k = 0; k < 2; ++k) \
        acc[ai][bj][m][n] = __builtin_amdgcn_mfma_f32_16x16x32_bf16(Bt[n][k], At[m][k], acc[ai][bj][m][n], 0, 0, 0); __builtin_amdgcn_s_setprio(0); } while (0)
#define PG8_WAIT_V(n) asm volatile("s_waitcnt vmcnt(" #n ")" ::: "memory")
#define PG8_WAIT_L(n) asm volatile("s_waitcnt lgkmcnt(" #n ")" ::: "memory")
#define PG8_BAR __builtin_amdgcn_s_barrier()
#define PG8_SCHED __builtin_amdgcn_sched_barrier(0)
    Unit cur, nxt; int ui = 0;
    if (!S.next(0, cur)) return;
    f32x4 acc[2][2][4][2];
#pragma unroll
    for (int a = 0; a < 2; ++a)
#pragma unroll
        for (int b = 0; b < 2; ++b)
#pragma unroll
            for (int m = 0; m < 4; ++m)
#pragma unroll
                for (int n = 0; n < 2; ++n) acc[a][b][m][n] = (f32x4){0.f, 0.f, 0.f, 0.f};
    bf16x8 At[4][2], B0[2][2], B1[2][2];
    const char* cA = (const char*)g.A + (size_t)cur.pm * tstep; const char* cB = (const char*)g.Bt + (size_t)cur.pn * tstep;
    PG8_STAGE(PG8_SB(0, 0), cB, voffB); PG8_STAGE(PG8_SB(0, 1), cB + hstep, voffB); PG8_STAGE(PG8_SA(0, 0), cA, voffA); PG8_STAGE(PG8_SA(0, 1), cA + hstep, voffA);
    if (wr == 1) PG8_BAR;
    PG8_WAIT_V(2); PG8_BAR;
    PG8_STAGE(PG8_SB(1, 0), cB + kstep, voffB); PG8_STAGE(PG8_SA(1, 0), cA + kstep, voffA); PG8_STAGE(PG8_SB(1, 1), cB + hstep + kstep, voffB);
    PG8_WAIT_V(6); PG8_BAR;
    for (;;) {
        const bool has_next = S.next(ui + 1, nxt);
        const char* nA = has_next ? (const char*)g.A + (size_t)nxt.pm * tstep : cA; const char* nB = has_next ? (const char*)g.Bt + (size_t)nxt.pn * tstep : cB;
        for (int t = 0; t < nt; t += 2) {
            const bool last = (t == nt - 2);
            const char* a1 = cA + (size_t)(t + 1) * kstep;
            const char* a2 = last ? nA : cA + (size_t)(t + 2) * kstep; const char* b2 = last ? nB : cB + (size_t)(t + 2) * kstep;
            const char* a3 = a2 + kstep; const char* b3 = b2 + kstep;
            PG8_LDB(B0, 0, 0); PG8_LDB(B1, 0, 1); PG8_SCHED; PG8_LDA(At, 0, 0); PG8_STAGE(PG8_SA(1, 1), a1 + hstep, voffA);
            PG8_WAIT_V(8); PG8_WAIT_L(0); PG8_BAR; PG8_MMA(0, 0, At, B0); PG8_MMA(0, 1, At, B1); PG8_BAR; PG8_SCHED;
            PG8_LDA(At, 0, 1); PG8_STAGE(PG8_SB(0, 0), b2, voffB); PG8_STAGE(PG8_SB(0, 1), b2 + hstep, voffB); PG8_STAGE(PG8_SA(0, 0), a2, voffA);
            PG8_WAIT_V(8); PG8_WAIT_L(0); PG8_BAR; PG8_MMA(1, 0, At, B0); PG8_MMA(1, 1, At, B1); PG8_BAR; PG8_SCHED;
            PG8_LDB(B0, 1, 0); PG8_LDB(B1, 1, 1); PG8_SCHED; PG8_LDA(At, 1, 0); PG8_STAGE(PG8_SA(0, 1), a2 + hstep, voffA);
            PG8_WAIT_V(8); PG8_WAIT_L(0); PG8_BAR; PG8_MMA(0, 0, At, B0); PG8_MMA(0, 1, At, B1); PG8_BAR; PG8_SCHED;
            PG8_LDA(At, 1, 1); PG8_STAGE(PG8_SB(1, 0), b3, voffB); PG8_STAGE(PG8_SB(1, 1), b3 + hstep, voffB); PG8_STAGE(PG8_SA(1, 0), a3, voffA);
            PG8_WAIT_V(8); PG8_WAIT_L(0); PG8_BAR; PG8_MMA(1, 0, At, B0); PG8_MMA(1, 1, At, B1); PG8_BAR; PG8_SCHED;
        }
        if (wr == 0) PG8_BAR;
        E(acc, cur, wr, wc, fr, fq, (LAS float*)(lds + STAGE_BYTES));
        if (!has_next) break;
#pragma unroll
        for (int a = 0; a < 2; ++a)
#pragma unroll
            for (int b = 0; b < 2; ++b)
#pragma unroll
                for (int m = 0; m < 4; ++m)
#pragma unroll
                    for (int n = 0; n < 2; ++n) acc[a][b][m][n] = (f32x4){0.f, 0.f, 0.f, 0.f};
        cur = nxt; cA = nA; cB = nB; ++ui;
        if (wr == 1) PG8_BAR;
    }
    PG8_WAIT_V(0);
    PG8_BAR;
#undef PG8_SA
#undef PG8_SB
#undef PG8_STAGE
#undef PG8_LDA
#undef PG8_LDB
#undef PG8_MMA
#undef PG8_WAIT_V
#undef PG8_WAIT_L
#undef PG8_BAR
#undef PG8_SCHED
}
}

template <int KIND> struct EpiHead {
    bf16_t* R;
    const float* gq; const float* gk; const float* gm;
    const float* ss;
    const f32x2* tab;
    __device__ __forceinline__ void operator()(f32x4 (&acc)[2][2][4][2], const pg8::Unit& u, int wr, int wc, int fr, int fq, LAS float* xl) const {
        int ln_;
        { const int t_ = tid_now(wr * 4 + wc); fr = t_ & 15; fq = (t_ >> 4) & 3; ln_ = t_ & 63; }
        const int rloc = wr * 64 + fr;
        const int rbase = u.pm * 256 + rloc;
        const int pb = wc * 4 + fq;
        bool norm[2], rowmajor[2]; const float* g[2]; bf16_t* base[2]; int bs[2], gcol[2]; int rope = 0, dl = 0, sh = 12;
#pragma unroll
        for (int bj = 0; bj < 2; ++bj) {
            const int hd = u.pn * 2 + bj; norm[bj] = false; rowmajor[bj] = false; g[bj] = nullptr; base[bj] = R; bs[bj] = 0; gcol[bj] = 0;
            if (KIND == 0) {
                if (hd < 72) { const int tsel = hd / 24, gg = (hd >> 3) % 3, h = hd & 7; norm[bj] = tsel < 2; if (tsel < 2) rope = 1; g[bj] = (tsel == 0 ? gq : gk) + gg * 128;
                    dl = 2 * gg; bs[bj] = 3 * 3 * 8 * 4096; base[bj] = R + (R_QKV / 2) + (size_t)((tsel * 3 + gg) * 8 + h) * 4096 * 128; }
                else if (hd < 76) { norm[bj] = true; g[bj] = gm; bs[bj] = 4 * 4096; base[bj] = R + (R_QM0 / 2) + (size_t)(hd - 72) * 4096 * 128; }
                else { rowmajor[bj] = true; gcol[bj] = (hd - 76) * 128; base[bj] = R + (R_GATE0 / 2); }
            } else if (KIND == 2) {
                if (hd < 8) { norm[bj] = true; rope = 2; g[bj] = gq; bs[bj] = 8 * 4096; base[bj] = R + (R_Q1 / 2) + (size_t)hd * 4096 * 128; }
                else if (hd < 10) { norm[bj] = true; rope = 2; g[bj] = gk; bs[bj] = 2 * 4096; base[bj] = R + (R_K1 / 2) + (size_t)(hd - 8) * 4096 * 128; }
                else if (hd < 12) { bs[bj] = 2 * 4096; base[bj] = R + (R_V1 / 2) + (size_t)(hd - 10) * 4096 * 128; }
                else if (hd < 16) { norm[bj] = true; g[bj] = gm; bs[bj] = 4 * 4096; base[bj] = R + (R_QM1 / 2) + (size_t)(hd - 12) * 4096 * 128; }
                else { rowmajor[bj] = true; gcol[bj] = (hd - 16) * 128; base[bj] = R + (R_GATE1 / 2); }
            } else {
                const int layer = hd >> 3, tt = (hd >> 2) & 1, mh = hd & 3; norm[bj] = tt == 0; g[bj] = gk + layer * 128; sh = 8; bs[bj] = 4 * 256;
                base[bj] = R + (size_t)(((layer * 2 + tt) * 8) * 4 + mh) * 256 * 128;
            }
        }
        const bool anynorm = norm[0] || norm[1];
        if (anynorm) {
#pragma unroll
        for (int ai = 0; ai < 2; ++ai)
#pragma unroll
            for (int m = 0; m < 4; ++m)
#pragma unroll
                for (int bj = 0; bj < 2; ++bj) {
                    const f32x4 a = acc[ai][bj][m][0], b = acc[ai][bj][m][1];
                    float s = (a.x * a.x + a.y * a.y) + (a.z * a.z + a.w * a.w) + (b.x * b.x + b.y * b.y) + (b.z * b.z + b.w * b.w);
                    s += shfl_xor_l(s, 16, ln_); s += shfl_xor_l(s, 32, ln_);
                    if (fq == 0) xl[((ai * 128 + m * 16 + rloc) * 2 + bj) * 4 + wc] = s;
                }
        }
        const int np = (rope == 2) ? 64 : 16;
        const bool dorope = (rope == 2) || (rope == 1 && pb < 4);
        f32x4 tc0 = (f32x4){1.f, 0.f, 1.f, 0.f}, tc1 = tc0;
        if (dorope) { const f32x4* tp = as_global((const f32x4*)(tab + (size_t)(rbase & 4095) * np + 4 * pb)); tc0 = tp[0]; tc1 = tp[1]; }
        float fac[2][4][2];
#pragma unroll
        for (int ai = 0; ai < 2; ++ai)
#pragma unroll
            for (int m = 0; m < 4; ++m) {
                float r_ = 1.f;
                if (KIND == 2) { const f32x4 a = *(const f32x4*)(ss + (size_t)(rbase + ai * 128 + m * 16) * 4); r_ = rsqrtf(((a.x + a.y) + (a.z + a.w)) * (1.0f / 1024.0f) + EPS); }
                fac[ai][m][0] = r_; fac[ai][m][1] = r_;
            }
        if (anynorm) { asm volatile("s_waitcnt lgkmcnt(0)" ::: "memory"); __builtin_amdgcn_s_barrier(); asm volatile("" ::: "memory"); }
#pragma unroll
        for (int ai = 0; ai < 2; ++ai)
#pragma unroll
            for (int m = 0; m < 4; ++m)
#pragma unroll
                for (int bj = 0; bj < 2; ++bj)
                    if (norm[bj]) {
                        const f32x4 pp = *(const LAS f32x4*)(xl + ((ai * 128 + m * 16 + rloc) * 2 + bj) * 4);
                        const float r_ = fac[ai][m][bj];
                        fac[ai][m][bj] = r_ * rsqrtf(((pp.x + pp.y) + (pp.z + pp.w)) * (r_ * r_) * (1.0f / 128.0f) + EPS);
                    }
        int dlo = pb * 8, dhi = pb * 8 + 4;
        if (rope == 1 && pb < 4) { dlo = 4 * pb; dhi = 16 + 4 * pb; }
        if (rope == 2) { dlo = 4 * pb; dhi = 64 + 4 * pb; }
        f32x4 g0[2], g1[2];
#pragma unroll
        for (int bj = 0; bj < 2; ++bj) { g0[bj] = (f32x4){1.f, 1.f, 1.f, 1.f}; g1[bj] = g0[bj]; if (norm[bj]) { g0[bj] = *(const f32x4*)(g[bj] + dlo); g1[bj] = *(const f32x4*)(g[bj] + dhi); } }
#pragma unroll
        for (int ai = 0; ai < 2; ++ai)
#pragma unroll
            for (int m = 0; m < 4; ++m) {
                const int row = rbase + ai * 128 + m * 16, t = row & ((1 << sh) - 1);
                const f32x4 c01 = tc0, c23 = tc1;
                if (dorope && (ai * 4 + m) < 7) {
                    const int nrow = rbase + ((ai * 4 + m + 1) >> 2) * 128 + ((ai * 4 + m + 1) & 3) * 16;
                    const f32x4* tp = as_global((const f32x4*)(tab + (size_t)(nrow & 4095) * np + 4 * pb)); tc0 = tp[0]; tc1 = tp[1]; }
                const f32x4 cs = (f32x4){c01.x, c01.z, c23.x, c23.z}, sn = (f32x4){c01.y, c01.w, c23.y, c23.w};
                const int p = t;
#pragma unroll
                for (int bj = 0; bj < 2; ++bj) {
                    const float f = fac[ai][m][bj];
                    f32x4 v0 = acc[ai][bj][m][0] * f * g0[bj], v1 = acc[ai][bj][m][1] * f * g1[bj];
                    if (dorope) { const f32x4 o0 = v0 * cs - v1 * sn, o1 = v1 * cs + v0 * sn; v0 = o0; v1 = o1; }
                    u32x4 w; w.x = cvt_pk_bf16(v0[0], v0[1]); w.y = cvt_pk_bf16(v0[2], v0[3]); w.z = cvt_pk_bf16(v1[0], v1[1]); w.w = cvt_pk_bf16(v1[2], v1[3]);
                    bf16_t* dst;
                    if (rowmajor[bj]) dst = base[bj] + (size_t)row * BRW + gcol[bj] + pb * 8;
                    else dst = base[bj] + ((size_t)(row >> sh) * bs[bj] + p) * 128 + pb * 8;
                    *(u32x4*)dst = w;
                }
                asm volatile("" ::: "memory");
            }
    }
};

struct EpiPlain {
    bf16_t* O; int ldc;
    __device__ __forceinline__ void operator()(f32x4 (&acc)[2][2][4][2], const pg8::Unit& u, int wr, int wc, int fr, int fq, LAS float* xl) const {
        { const int t_ = tid_now(wr * 4 + wc); fr = t_ & 15; fq = (t_ >> 4) & 3; }
        const int rbase = u.pm * 256 + wr * 64 + fr, cbase = u.pn * 256 + wc * 32 + 8 * fq;
#pragma unroll
        for (int ai = 0; ai < 2; ++ai)
#pragma unroll
            for (int m = 0; m < 4; ++m)
#pragma unroll
                for (int bj = 0; bj < 2; ++bj) { const f32x4 v0 = acc[ai][bj][m][0], v1 = acc[ai][bj][m][1];
                    u32x4 w; w.x = cvt_pk_bf16(v0[0], v0[1]); w.y = cvt_pk_bf16(v0[2], v0[3]); w.z = cvt_pk_bf16(v1[0], v1[1]); w.w = cvt_pk_bf16(v1[2], v1[3]);
                    *(u32x4*)(O + (size_t)(rbase + ai * 128 + m * 16) * ldc + cbase + bj * 128) = w; }
    }
};
template <bool FIRST> struct EpiRes {
    const float* xi; float* xo; bf16_t* A1; float* ss;
    __device__ __forceinline__ void operator()(f32x4 (&acc)[2][2][4][2], const pg8::Unit& u, int wr, int wc, int fr, int fq, LAS float* xl) const {
        int ln_;
        { const int t_ = tid_now(wr * 4 + wc); fr = t_ & 15; fq = (t_ >> 4) & 3; ln_ = t_ & 63; }
        const int rbase = u.pm * 256 + wr * 64 + fr, cbase = u.pn * 256 + wc * 32 + 8 * fq;
#pragma unroll
        for (int ai = 0; ai < 2; ++ai)
#pragma unroll
            for (int m = 0; m < 4; ++m) {
                const int row = rbase + ai * 128 + m * 16; float s = 0.f;
#pragma unroll
                for (int bj = 0; bj < 2; ++bj) {
                    const size_t off = (size_t)row * DM + cbase + bj * 128;
                    const f32x4 xa = *(const f32x4*)(xi + off), xb = *(const f32x4*)(xi + off + 4);
                    const f32x4 v0 = acc[ai][bj][m][0] + xa, v1 = acc[ai][bj][m][1] + xb;
                    *(f32x4*)(xo + off) = v0; *(f32x4*)(xo + off + 4) = v1;
                    if (FIRST) {
                        u32x4 w; w.x = cvt_pk_bf16(v0[0], v0[1]); w.y = cvt_pk_bf16(v0[2], v0[3]); w.z = cvt_pk_bf16(v1[0], v1[1]); w.w = cvt_pk_bf16(v1[2], v1[3]);
                        *(u32x4*)(A1 + off) = w;
                        s += (v0.x * v0.x + v0.y * v0.y) + (v0.z * v0.z + v0.w * v0.w) + (v1.x * v1.x + v1.y * v1.y) + (v1.z * v1.z + v1.w * v1.w);
                    }
                }
                if (FIRST) { s += shfl_xor_l(s, 16, ln_); s += shfl_xor_l(s, 32, ln_); if (fq == 0) xl[(ai * 128 + m * 16 + wr * 64 + fr) * 4 + wc] = s; }
                asm volatile("" ::: "memory");
            }
        if (FIRST) {
            asm volatile("s_waitcnt lgkmcnt(0)" ::: "memory"); __builtin_amdgcn_s_barrier(); asm volatile("" ::: "memory");
            if (wc == 0 && fq == 0) {
#pragma unroll
                for (int ai = 0; ai < 2; ++ai)
#pragma unroll
                    for (int m = 0; m < 4; ++m) { const f32x4 pp = *(const LAS f32x4*)(xl + (ai * 128 + m * 16 + wr * 64 + fr) * 4);
                        ss[(size_t)(rbase + ai * 128 + m * 16) * 4 + u.pn] = (pp.x + pp.y) + (pp.z + pp.w); }
            }
        }
    }
};

namespace att {
constexpr int D = 128, NW = 8, QBLK = 32, KVBLK = 64;
constexpr float THR = 8.f;
#ifndef ATT_SDEPTH
#define ATT_SDEPTH 2
#endif
constexpr int SDEPTH = ATT_SDEPTH;
constexpr size_t SHM_V = KVBLK * D * 2, SHM_K = KVBLK * D * 2, SHM_ATTN = 2 * SHM_V + 2 * SHM_K + NW * 64 * 4;
#define KSWZ(row, colB) ((row) * 256 + ((colB) ^ (((row) & 7) << 4)))
#define SBAR() __builtin_amdgcn_sched_barrier(0)
__device__ __forceinline__ int crow(int r, int hi) { return (r & 3) + 8 * (r >> 2) + 4 * hi; }
__device__ __forceinline__ unsigned cvtpk(float lo, float hi) { unsigned r; asm volatile("v_cvt_pk_bf16_f32 %0, %1, %2" : "=v"(r) : "v"(lo), "v"(hi)); return r; }
__device__ __forceinline__ void band_mask(f32x16& p0, f32x16& p1, int base) {
#pragma unroll
    for (int r = 0; r < 16; ++r) { const int c = (r & 3) + 8 * (r >> 2);
        if ((unsigned)(base + c + 64) > 128u) p0[r] = -INFINITY;
        if ((unsigned)(base + c + 32 + 64) > 128u) p1[r] = -INFINITY; }
}
__device__ __forceinline__ void partialSM(f32x16& p0, f32x16& p1, float& m_reg, float& mn, float& alpha) {
    constexpr float C = SCALE * 1.4426950408889634f;
    float pmax = p0[0];
#pragma unroll
    for (int r = 1; r < 16; ++r) pmax = fmaxf(pmax, p0[r]);
#pragma unroll
    for (int r = 0; r < 16; ++r) pmax = fmaxf(pmax, p1[r]);
    { auto rr = __builtin_amdgcn_permlane32_swap(__float_as_uint(pmax), __float_as_uint(pmax), false, false);
      pmax = fmaxf(__uint_as_float(rr[0]), __uint_as_float(rr[1])); }
    if (__builtin_expect(__all(pmax - m_reg <= THR / SCALE), 1)) { mn = m_reg; alpha = 1.f; }
    else { mn = fmaxf(m_reg, pmax); alpha = __builtin_amdgcn_exp2f((m_reg - mn) * C); m_reg = mn; }
    float mnC = -mn * C;
#pragma unroll
    for (int r = 0; r < 16; ++r) p0[r] = fmaf(p0[r], C, mnC);
#pragma unroll
    for (int r = 0; r < 16; ++r) p1[r] = fmaf(p1[r], C, mnC);
#pragma unroll
    for (int r = 0; r < 16; ++r) p0[r] = __builtin_amdgcn_exp2f(p0[r]);
}
__device__ __forceinline__ void finishSM(f32x16& p0, f32x16& p1, float alpha, float& l_reg, bf16x8& pa0, bf16x8& pa1, bf16x8& pa2, bf16x8& pa3) {
#pragma unroll
    for (int r = 0; r < 16; ++r) p1[r] = __builtin_amdgcn_exp2f(p1[r]);
    float ps = 0;
#pragma unroll
    for (int r = 0; r < 16; ++r) ps += p0[r];
#pragma unroll
    for (int r = 0; r < 16; ++r) ps += p1[r];
    { auto rr = __builtin_amdgcn_permlane32_swap(__float_as_uint(ps), __float_as_uint(ps), false, false);
      ps = __uint_as_float(rr[0]) + __uint_as_float(rr[1]); }
    l_reg = l_reg * alpha + ps;
#define PK4(P, BASE, OUT) do { unsigned a0 = cvtpk(P[BASE + 0], P[BASE + 1]), a1 = cvtpk(P[BASE + 2], P[BASE + 3]);   \
    unsigned b0 = cvtpk(P[BASE + 4], P[BASE + 5]), b1 = cvtpk(P[BASE + 6], P[BASE + 7]);                              \
    auto r0 = __builtin_amdgcn_permlane32_swap(a0, b0, false, false); auto r1 = __builtin_amdgcn_permlane32_swap(a1, b1, false, false); \
    u32x4 w = {r0[0], r1[0], r0[1], r1[1]}; OUT = *reinterpret_cast<bf16x8*>(&w); } while (0)
    PK4(p0, 0, pa0); PK4(p0, 8, pa1); PK4(p1, 0, pa2); PK4(p1, 8, pa3);
#undef PK4
}
__device__ __forceinline__ void qkt(f32x16& p0, f32x16& p1, const bf16_t* Ks, const bf16x8* qr, int r32, int hi) {
    p0 = f32x16{}; p1 = f32x16{};
#pragma unroll
    for (int d0 = 0; d0 < 8; ++d0) { int cb = (d0 * 16 + hi * 8) * 2;
        bf16x8 b0 = *reinterpret_cast<const bf16x8*>((const char*)Ks + KSWZ(r32, cb));
        bf16x8 b1 = *reinterpret_cast<const bf16x8*>((const char*)Ks + KSWZ(32 + r32, cb));
        p0 = __builtin_amdgcn_mfma_f32_32x32x16_bf16(b0, qr[d0], p0, 0, 0, 0);
        p1 = __builtin_amdgcn_mfma_f32_32x32x16_bf16(b1, qr[d0], p1, 0, 0, 0); }
}
__device__ __forceinline__ int v_st(int k, int c) { const int kk = (k & ~0xC) | ((k & 4) << 1) | ((k & 8) >> 1); return ((kk >> 3) * 4 + (c >> 5)) * 512 + ((kk & 7) * 32 + (c & 31)) * 2; }
__device__ __forceinline__ int v_rd_base(int lane) { return ((lane & 3) << 3) | (((lane >> 2) & 3) << 6) | (((lane >> 4) & 1) << 5) | (((lane >> 5) & 1) << 8); }
constexpr int v_rd_off(int d0, int ks, int half) { return d0 * 512 + ks * 4096 + half * 2048; }
template <int OFF> __device__ __forceinline__ s16x4 tr_read(int vb) {
    s16x4 r; asm volatile("ds_read_b64_tr_b16 %0, %1 offset:%2" : "=&v"(r) : "v"(vb), "i"(OFF) : "memory"); return r;
}
template <int D0> __device__ __forceinline__ void pv_one(f32x16& od, int vb, bf16x8 pa0, bf16x8 pa1, bf16x8 pa2, bf16x8 pa3) {
    const s16x4 l0 = tr_read<v_rd_off(D0, 0, 0)>(vb), h0 = tr_read<v_rd_off(D0, 0, 1)>(vb), l1 = tr_read<v_rd_off(D0, 1, 0)>(vb), h1 = tr_read<v_rd_off(D0, 1, 1)>(vb);
    const s16x4 l2 = tr_read<v_rd_off(D0, 2, 0)>(vb), h2 = tr_read<v_rd_off(D0, 2, 1)>(vb), l3 = tr_read<v_rd_off(D0, 3, 0)>(vb), h3 = tr_read<v_rd_off(D0, 3, 1)>(vb);
    asm volatile("s_waitcnt lgkmcnt(0)" ::: "memory"); SBAR();
#define PK(L, H) (bf16x8){L[0], L[1], L[2], L[3], H[0], H[1], H[2], H[3]}
    od = __builtin_amdgcn_mfma_f32_32x32x16_bf16(pa0, PK(l0, h0), od, 0, 0, 0);
    od = __builtin_amdgcn_mfma_f32_32x32x16_bf16(pa1, PK(l1, h1), od, 0, 0, 0);
    od = __builtin_amdgcn_mfma_f32_32x32x16_bf16(pa2, PK(l2, h2), od, 0, 0, 0);
    od = __builtin_amdgcn_mfma_f32_32x32x16_bf16(pa3, PK(l3, h3), od, 0, 0, 0);
#undef PK
}
__device__ __forceinline__ void pv_d0(f32x16* o, int vb, bf16x8 pa0, bf16x8 pa1, bf16x8 pa2, bf16x8 pa3) {
    pv_one<0>(o[0], vb, pa0, pa1, pa2, pa3); pv_one<1>(o[1], vb, pa0, pa1, pa2, pa3); pv_one<2>(o[2], vb, pa0, pa1, pa2, pa3); pv_one<3>(o[3], vb, pa0, pa1, pa2, pa3);
}

constexpr int STG_ROW = 136;
constexpr int STG_WAVE = 32 * STG_ROW * 2;
__device__ __forceinline__ void stage_o(const f32x16* o, const float* rli, bf16_t* stg, int r32, int hi) {
#pragma unroll
    for (int r = 0; r < 16; ++r) { const int orow = crow(r, hi);
#pragma unroll
        for (int d0 = 0; d0 < 4; ++d0) stg[orow * STG_ROW + d0 * 32 + r32] = (bf16_t)f2bf(o[d0][r] * rli[r]); }
    asm volatile("s_waitcnt lgkmcnt(0)" ::: "memory");
}
struct EpiDil {
    bf16_t* O; float* lse; int RS;
    __device__ __forceinline__ void operator()(const f32x16* o, const float* rli, float l_reg, float m_reg, int wid, int lane, bf16_t* stg) const {
        asm volatile("" : "+v"(lane)); __builtin_assume(lane >= 0 && lane < 64);
        const int r32 = lane & 31, hi = lane >> 5;
        stage_o(o, rli, stg, r32, hi);
        bf16_t* Ow = O + (size_t)(wid * QBLK) * RS;
#pragma unroll
        for (int i = 0; i < 8; ++i) { const int row = i * 4 + (lane >> 4), ch = lane & 15;
            const u32x4 v = *(const u32x4*)(stg + row * STG_ROW + ch * 8); *(u32x4*)(Ow + (size_t)row * RS + ch * 8) = v; }
        if (hi == 0) lse[(wid * QBLK + r32) * (RS >> 7)] = SCALE * m_reg + __logf(l_reg);
    }
};
struct EpiGate {
    bf16_t* Y; const bf16_t* G;
    __device__ __forceinline__ void operator()(const f32x16* o, const float* rli, float l_reg, float m_reg, int wid, int lane, bf16_t* stg) const {
        asm volatile("" : "+v"(lane)); __builtin_assume(lane >= 0 && lane < 64);
        const int r32 = lane & 31, hi = lane >> 5;
        stage_o(o, rli, stg, r32, hi);
#pragma unroll
        for (int i = 0; i < 8; ++i) { const int row = i * 4 + (lane >> 4), ch = lane & 15; const size_t idx = (size_t)(wid * QBLK + row) * BRW + ch * 8;
            const bf16x8 gv = *(const bf16x8*)(G + idx); const bf16x8 ov = *(const bf16x8*)(stg + row * STG_ROW + ch * 8);
            float rr[8];
#pragma unroll
            for (int e = 0; e < 8; ++e) rr[e] = bf2f((unsigned short)ov[e]) * silu(bf2f((unsigned short)gv[e]));
            u32x4 w; w.x = pk2(rr[0], rr[1]); w.y = pk2(rr[2], rr[3]); w.z = pk2(rr[4], rr[5]); w.w = pk2(rr[6], rr[7]);
            *(u32x4*)(Y + idx) = w; }
    }
};

__device__ __forceinline__ void glds16s(unsigned voff, const void* sbase, unsigned lds_dst) { unsigned keep;
    asm volatile("s_mov_b32 %0, m0\n\ts_mov_b32 m0, %3\n\ts_nop 0\n\tglobal_load_lds_dwordx4 %1, %2\n\ts_mov_b32 m0, %0" : "=&s"(keep) : "v"(voff), "s"(sbase), "s"(lds_dst) : "memory"); }

template <bool MASK, class Epi>
__device__ __forceinline__ void attn_unit(const int tid, const bf16_t* Qb, const bf16_t* Kh, const bf16_t* Vh, int NT, int dq, char* lds, const Epi& E, const int rs_arg = D) {
    const int RS = MASK ? rs_arg : D;
    const int wid = __builtin_amdgcn_readfirstlane(tid >> 6), lane = tid & 63, r32 = lane & 31, hi = lane >> 5;
    constexpr int NSLOT = 4;
    bf16_t* V_lds = (bf16_t*)lds; bf16_t* K_lds = (bf16_t*)(lds + NSLOT * SHM_V);
    float* ws = (float*)(lds + NSLOT * SHM_V + NSLOT * SHM_K) + wid * 64; float* li_l = ws; float* al_l = ws + 32;
    float m_reg = -1e30f, l_reg = 0; f32x16 o[4] = {}; bf16x8 qr[8];
    const bf16_t* Qw = Qb + (long)(wid * QBLK + r32) * RS + hi * 8;
#pragma unroll
    for (int d0 = 0; d0 < 8; ++d0) qr[d0] = *reinterpret_cast<const bf16x8*>(Qw + d0 * 16);
    const int vb0 = (int)(uintptr_t)V_lds + v_rd_base(lane);
    const int mb0 = dq + 4 * hi - (wid * QBLK + r32);
    unsigned kof[2], vof[2];
#pragma unroll
    for (int i = 0; i < 2; ++i) { const int p = wid * 2 + i;
        const int krow = p * 4 + (lane >> 4), kc = (lane & 15) ^ (krow & 7); kof[i] = (unsigned)(krow * RS * 2 + kc * 16);
        const int sub = p * 2 + (lane >> 5), kk = (sub >> 2) * 8 + ((lane & 31) >> 2), k = (kk & ~0xC) | ((kk & 4) << 1) | ((kk & 8) >> 1), c = (sub & 3) * 32 + 8 * (lane & 3);
        vof[i] = (unsigned)(k * RS * 2 + c * 2); }
    const unsigned ldsV = (unsigned)(uintptr_t)V_lds + (unsigned)wid * 2048u, ldsK = (unsigned)(uintptr_t)K_lds + (unsigned)wid * 2048u;
#define DMA_TILE(t, slot) do { const char* kt_ = (const char*)(Kh + (long)(t) * KVBLK * RS); const char* vt_ = (const char*)(Vh + (long)(t) * KVBLK * RS); \
    const unsigned so_ = (unsigned)(slot) * (unsigned)SHM_V; \
    glds16s(kof[0], kt_, (unsigned)__builtin_amdgcn_readfirstlane(ldsK + so_)); glds16s(kof[1], kt_, (unsigned)__builtin_amdgcn_readfirstlane(ldsK + so_ + 1024u)); \
    glds16s(vof[0], vt_, (unsigned)__builtin_amdgcn_readfirstlane(ldsV + so_)); glds16s(vof[1], vt_, (unsigned)__builtin_amdgcn_readfirstlane(ldsV + so_ + 1024u)); } while (0)
#define WAIT_BAR(N) do { asm volatile("s_waitcnt vmcnt(" #N ")" ::: "memory"); __syncthreads(); } while (0)
#define RESC(a) do { if (__any((a) < 1.f)) { if (hi == 0) al_l[r32] = (a); asm volatile("s_waitcnt lgkmcnt(0)" ::: "memory"); \
    _Pragma("unroll") for (int d = 0; d < 4; ++d) _Pragma("unroll") for (int r = 0; r < 16; ++r) o[d][r] *= al_l[crow(r, hi)]; } } while (0)
#define MSK(P0, P1, t) do { if (MASK) band_mask(P0, P1, mb0 + (t) * KVBLK); } while (0)
    f32x16 pA0, pA1, pB0, pB1; float mnA, mnB, alA, alB; bf16x8 pa0, pa1, pa2, pa3;
    const int widu = wid;
    if (widu >= 4) __builtin_amdgcn_s_setprio(1);
#define ACT(t) (!MASK || ((dq + (t) * KVBLK + 127 >= widu * QBLK) && (dq + (t) * KVBLK <= widu * QBLK + 95)))
    bool aA, aB;
    DMA_TILE(0, 0); DMA_TILE(1, 1); DMA_TILE(2, 2);
    WAIT_BAR(8);
    aA = ACT(0);
    if (aA) { qkt(pA0, pA1, K_lds, qr, r32, hi); MSK(pA0, pA1, 0); partialSM(pA0, pA1, m_reg, mnA, alA); } else alA = 1.f;
    RESC(alA);
    WAIT_BAR(4);
    int sc_ = 1, sp_ = 0, sn_ = 2, sf_ = 3;
#define STEP(PC0, PC1, PP0, PP1, aC, aP, alC, alP, mnC, t) do { \
        const bool more_ = (t) + 2 < NT; if (more_) DMA_TILE((t) + 2, sf_); \
        aC = ACT(t); \
        SBAR(); if (aC) { qkt(PC0, PC1, (bf16_t*)((char*)K_lds + sc_ * SHM_K), qr, r32, hi); MSK(PC0, PC1, t); } \
        if (aP) finishSM(PP0, PP1, alP, l_reg, pa0, pa1, pa2, pa3); SBAR(); \
        if (aP) pv_d0(o, vb0 + sp_ * (int)SHM_V, pa0, pa1, pa2, pa3); \
        if (aC) partialSM(PC0, PC1, m_reg, mnC, alC); else alC = 1.f; \
        RESC(alC); \
        if (more_) { WAIT_BAR(4); } else { WAIT_BAR(0); }           \
        { const int t_ = sp_; sp_ = sc_; sc_ = sn_; sn_ = sf_; sf_ = t_; } } while (0)
    int j = 1;
    for (; j + 1 < NT; j += 2) {
        STEP(pB0, pB1, pA0, pA1, aB, aA, alB, alA, mnB, j);
        STEP(pA0, pA1, pB0, pB1, aA, aB, alA, alB, mnA, j + 1);
    }
    aB = ACT(NT - 1);
    SBAR(); if (aB) { qkt(pB0, pB1, (bf16_t*)((char*)K_lds + sc_ * SHM_K), qr, r32, hi); MSK(pB0, pB1, NT - 1); }
    if (aA) finishSM(pA0, pA1, alA, l_reg, pa0, pa1, pa2, pa3); SBAR();
    if (aA) pv_d0(o, vb0 + sp_ * (int)SHM_V, pa0, pa1, pa2, pa3);
    if (aB) partialSM(pB0, pB1, m_reg, mnB, alB); else alB = 1.f;
    RESC(alB);
    if (aB) { finishSM(pB0, pB1, alB, l_reg, pa0, pa1, pa2, pa3); SBAR();
        pv_d0(o, vb0 + sc_ * (int)SHM_V, pa0, pa1, pa2, pa3); }
#undef ACT
#undef STEP
    if (hi == 0) li_l[r32] = l_reg; asm volatile("s_waitcnt lgkmcnt(0)" ::: "memory");
    float rli[16];
#pragma unroll
    for (int r = 0; r < 16; ++r) rli[r] = __builtin_amdgcn_rcpf(li_l[crow(r, hi)]);
    __builtin_amdgcn_s_setprio(0);
    __syncthreads();
    E(o, rli, l_reg, m_reg, wid, lane, (bf16_t*)(lds + wid * STG_WAVE));
    __syncthreads();
#undef DMA_TILE
#undef WAIT_BAR
#undef RESC
#undef MSK
}
}

#define XB_TMO      128
#define XB_XCNT(j)  (256  + 64 * (j))
#define XB_XSUB(j)  (1280 + 64 * (j))
#define XB_XGEN(j)  (2304 + 64 * (j))
#define XB_TOP      3328
#define XB_TOPGEN   3392
#define XCD_BAR_WORDS 3456
#define XB_SPIN_CAP (1u << 18)
__device__ __forceinline__ unsigned xb_ld(unsigned* p)              { return __hip_atomic_load(p, __ATOMIC_RELAXED, __HIP_MEMORY_SCOPE_AGENT); }
__device__ __forceinline__ unsigned xb_add(unsigned* p, unsigned v) { return __hip_atomic_fetch_add(p, v, __ATOMIC_RELAXED, __HIP_MEMORY_SCOPE_AGENT); }
__device__ __forceinline__ unsigned xb_xcc_id() { return (unsigned)__builtin_amdgcn_s_getreg((3 << 11) | 20) & 0xFu; }
#define XB_SPIN(cond, bar) do { unsigned _sp = 0; while (cond) { __builtin_amdgcn_s_sleep(1); \
    if ((++_sp & 255u) == 0u) { if (xb_ld(&(bar)[XB_TMO])) break; if (_sp > XB_SPIN_CAP) { atomicAdd(&(bar)[XB_TMO], 1u); break; } } } } while (0)
struct XcdBarrier { unsigned* bar; unsigned x; volatile LAS unsigned* st; };
__device__ __forceinline__ XcdBarrier xcd_barrier_post(unsigned* bar, volatile LAS unsigned* st) {
    XcdBarrier b; b.bar = bar; b.x = xb_xcc_id(); b.st = st;
    if (threadIdx.x == 0) (void)xb_add(&bar[XB_XCNT(b.x)], 1u);
    return b;
}
__device__ __forceinline__ void xcd_barrier_complete(unsigned* bar, unsigned x, unsigned& nloc, unsigned& nx) {
    const unsigned G = gridDim.x * gridDim.y * gridDim.z;
    unsigned sum, cnt, mine, sp = 0u;
    for (;;) {
        sum = 0u; cnt = 0u; mine = 0u;
#pragma unroll
        for (unsigned j = 0; j < 16; ++j) { const unsigned c = xb_ld(&bar[XB_XCNT(j)]); sum += c; cnt += (c > 0u) ? 1u : 0u; mine = (j == x) ? c : mine; }
        if (sum == G) break;
        __builtin_amdgcn_s_sleep(1);
        if ((++sp & 255u) == 0u) { if (xb_ld(&bar[XB_TMO])) break; if (sp > XB_SPIN_CAP) { atomicAdd(&bar[XB_TMO], 1u); break; } }
    }
    nloc = mine > 0u ? mine : 1u; nx = cnt > 0u ? cnt : 1u;
}
__device__ __forceinline__ void xcd_barrier(const XcdBarrier& b, const int wave_s) {
    asm volatile("s_waitcnt vmcnt(0)" ::: "memory");
    __syncthreads();
    if (tid_now(wave_s) == 0) {
        unsigned* bar = b.bar;
        __builtin_amdgcn_s_waitcnt(0);
        unsigned nloc = b.st[0], nx = b.st[1];
        if (nloc == 0u) { xcd_barrier_complete(bar, b.x, nloc, nx); b.st[0] = nloc; b.st[1] = nx; }
        const unsigned old = xb_add(&bar[XB_XSUB(b.x)], 1u);
        const unsigned gen = old / nloc;
        if (old + 1u == (gen + 1u) * nloc) {
            __builtin_amdgcn_fence(__ATOMIC_RELEASE, "agent");
            asm volatile("s_waitcnt vmcnt(0)" ::: "memory");
            const unsigned og = xb_add(&bar[XB_TOP], 1u);
            const unsigned tg = og / nx;
            if (og + 1u == (tg + 1u) * nx) xb_add(&bar[XB_TOPGEN], 1u);
            else XB_SPIN(xb_ld(&bar[XB_TOPGEN]) == tg, bar);
            __builtin_amdgcn_fence(__ATOMIC_ACQUIRE, "agent");
            xb_add(&bar[XB_XGEN(b.x)], 1u);
            asm volatile("s_waitcnt vmcnt(0)" ::: "memory");
        } else {
            XB_SPIN(xb_ld(&bar[XB_XGEN(b.x)]) == gen, bar);
            __builtin_amdgcn_fence(__ATOMIC_ACQUIRE, "agent");
            asm volatile("s_waitcnt vmcnt(0)" ::: "memory");
        }
    }
    __syncthreads();
}

__device__ __forceinline__ float wave_sum(float v, int lane) {
#pragma unroll
    for (int o = 1; o < 64; o <<= 1) v += shfl_xor_l(v, o, lane);
    return v;
}
template <int PERMK> __device__ __forceinline__ int srccol(int n) {
    if (PERMK == 0) return n;
    const int hd = n >> 7, p = n & 127, pb = p >> 3, nn = (p >> 2) & 1, j = p & 3;
    if (PERMK == 1) { if (hd < 48 && p < 32) return hd * 128 + 4 * pb + j + 16 * nn; return n; }
    if (hd < 10) return hd * 128 + 4 * pb + j + 64 * nn; return n;
}
template <int PERMK>
__device__ __forceinline__ void transpose_item(const float* W, int K, int N, bf16_t* WT, int row_off, const float* gk, LAS float* scr, int item, int lane) {
    const int nblk = N / 32, kb = item / nblk, nb = item % nblk, k0 = 64 * kb, n0 = 32 * nb;
    const int src = srccol<PERMK>(n0 + 4 * (lane & 7));
#pragma unroll
    for (int i = 0; i < 8; ++i) { const int kk = 8 * i + (lane >> 3); f32x4 v = *(const f32x4*)(W + (size_t)(k0 + kk) * N + src); if (gk) v = v * gk[k0 + kk];
        LAS float* d = scr + kk * 33 + 4 * (lane & 7); d[0] = v.x; d[1] = v.y; d[2] = v.z; d[3] = v.w; }
    asm volatile("s_waitcnt lgkmcnt(0)" ::: "memory");
    const int c = lane & 7;
#pragma unroll
    for (int j = 0; j < 4; ++j) { const int n = (lane >> 3) + 8 * j; const LAS float* s = scr + (8 * c) * 33 + n;
        u32x4 o; o.x = pk2(s[0 * 33], s[1 * 33]); o.y = pk2(s[2 * 33], s[3 * 33]); o.z = pk2(s[4 * 33], s[5 * 33]); o.w = pk2(s[6 * 33], s[7 * 33]);
        *(u32x4*)(WT + (size_t)(row_off + n0 + n) * K + k0 + 8 * c) = o; }
    asm volatile("s_waitcnt lgkmcnt(0)" ::: "memory");
}
__device__ __forceinline__ void rms_row_to_bf16(const float* xrow, bf16_t* orow, int lane) {
    const f32x4* xr = (const f32x4*)xrow + lane;
    f32x4 v[4]; float s = 0.f;
#pragma unroll
    for (int j = 0; j < 4; ++j) { v[j] = xr[64 * j]; s += (v[j].x * v[j].x + v[j].y * v[j].y) + (v[j].z * v[j].z + v[j].w * v[j].w); }
    const float rstd = rsqrtf(wave_sum(s, lane) * (1.f / DM) + EPS);
    unsigned long long* o8 = (unsigned long long*)orow + lane;
#pragma unroll
    for (int j = 0; j < 4; ++j) o8[64 * j] = (unsigned long long)pk2(v[j].x * rstd, v[j].y * rstd) | ((unsigned long long)pk2(v[j].z * rstd, v[j].w * rstd) << 32);
}
__device__ __forceinline__ f32x2 cos_sin(double pos, double lntheta, double e) {
    const double ang = pos * exp(-e * lntheta);
    const double rev = ang * 0.15915494309189533577;
    const float fr = (float)(rev - rint(rev));
    return (f32x2){__builtin_amdgcn_cosf(fr), __builtin_amdgcn_sinf(fr)};
}

typedef const __attribute__((address_space(4))) unsigned char* kptr_t;
__device__ __forceinline__ kptr_t kargs() { kptr_t p = (kptr_t)__builtin_amdgcn_kernarg_segment_ptr(); asm volatile("" : "+s"(p)); return p; }
#define KARG(field) as_global(*(decltype(Params::field) const __attribute__((address_space(4)))*)(kb + offsetof(Params, field)))
#define PHASE_PTRS() kptr_t kb = kargs(); unsigned char* ws = KARG(ws); unsigned char* dob = (unsigned char*)KARG(out); \
    bf16_t* Wb_t = (bf16_t*)(ws + WS_WB); bf16_t* Wo_t = (bf16_t*)(ws + WS_WO); bf16_t* Wm_t = (bf16_t*)(ws + WS_WM); bf16_t* MKV = (bf16_t*)(ws + WS_MKV); \
    f32x2* tabA = (f32x2*)(ws + WS_TABA); f32x2* tabB = (f32x2*)(ws + WS_TABB); float* SS1 = (float*)(ws + WS_SS1); float* LSE = (float*)(ws + WS_LSE); \
    bf16_t* Y = (bf16_t*)(ws + WS_Y); bf16_t* R = (bf16_t*)(ws + WS_R); \
    bf16_t* A0 = (bf16_t*)(ws + WS_Y); bf16_t* Wa_t = (bf16_t*)(ws + WS_WA); bf16_t* memA = (bf16_t*)(ws + WS_MEMA); \
    (void)Wb_t; (void)Wo_t; (void)Wm_t; (void)MKV; (void)tabA; (void)tabB; (void)SS1; (void)LSE; (void)Y; (void)R; (void)A0; (void)Wa_t; (void)memA
template <class T> __device__ __forceinline__ T* launder(T* p) { __attribute__((address_space(1))) T* g_ = (__attribute__((address_space(1))) T*)p; asm volatile("" : "+s"(g_)); return (T*)g_; }
struct Params {
    const float *x, *mem, *norm_g, *mem_norm_g, *w_mem_kv, *mem_qn_g, *mem_kn_g, *w_out, *w_in_a, *qn_a, *kn_a, *w_in_b, *qn_b, *kn_b;
    float* out; unsigned char* ws;
};
constexpr int LDS_BYTES = 147456;

__global__ void __launch_bounds__(512) mega_fwd(Params P) {
    extern __shared__ __attribute__((aligned(16))) unsigned char lds[];
    cg::grid_group grid = cg::this_grid();
    LAS unsigned char* lds3 = (LAS unsigned char*)lds;
    const int tid = threadIdx.x, lane = tid & 63, wave = __builtin_amdgcn_readfirstlane(tid >> 6);
    const int G = gridDim.x, bx = blockIdx.x;
    volatile LAS unsigned* MISC = (volatile LAS unsigned*)(lds3 + LDS_BYTES - 64);
    if (tid < 16) MISC[tid] = 0u;
    __syncthreads();
    { kptr_t kb = kargs(); (void)xcd_barrier_post((unsigned*)(KARG(ws) + WS_BAR), MISC); }
#define GRID_BAR() do { kptr_t kb = kargs(); XcdBarrier b_; b_.bar = (unsigned*)(KARG(ws) + WS_BAR); b_.x = xb_xcc_id(); b_.st = (volatile LAS unsigned*)(lds3 + LDS_BYTES - 64); xcd_barrier(b_, wave); } while (0)
#ifndef P1_WGM
#define P1_WGM 8
#endif
#ifndef REP_P0
#define REP_P0 1
#endif
#ifndef REP_P1
#define REP_P1 1
#endif
#ifndef REP_P5
#define REP_P5 1
#endif
#ifndef REP_P6
#define REP_P6 1
#endif
#ifndef REP_P3
#define REP_P3 1
#endif
#ifndef REP_P4
#define REP_P4 1
#endif
#ifndef SKIP_P0
#pragma unroll 1
    for (int rep = 0; rep < REP_P0; ++rep) {
        PHASE_PTRS();
        const int t0 = tid_now(wave); const int lane = t0 & 63;
        LAS float* scr = (LAS float*)(lds3 + wave * 16384);
        const int gw = bx * 8 + wave, NGW = G * 8;
        constexpr int IA = (DM / 64) * (INA / 32), IB = (DM / 64) * (INB / 32), IO = (BRW / 64) * (DM / 32), IM = (DM / 64) * (DM / 32);
        constexpr int NITEMS = IA + IB + 2 * IO + 2 * IM;
        for (int it = gw; it < NITEMS; it += NGW) {
            int r = it;
            if (r < IA) { transpose_item<1>(KARG(w_in_a), DM, INA, Wa_t, 0, KARG(norm_g), scr, r, lane); continue; } r -= IA;
            if (r < IB) { transpose_item<2>(KARG(w_in_b), DM, INB, Wb_t, 0, KARG(norm_g) + DM, scr, r, lane); continue; } r -= IB;
            if (r < IO) { transpose_item<0>(KARG(w_out), BRW, DM, Wo_t, 0, nullptr, scr, r, lane); continue; } r -= IO;
            if (r < IO) { transpose_item<0>(KARG(w_out) + (size_t)BRW * DM, BRW, DM, Wo_t + (size_t)DM * BRW, 0, nullptr, scr, r, lane); continue; } r -= IO;
            if (r < IM) { transpose_item<0>(KARG(w_mem_kv), DM, DM, Wm_t, 0, KARG(mem_norm_g), scr, r, lane); continue; } r -= IM;
            transpose_item<0>(KARG(w_mem_kv) + (size_t)DM * DM, DM, DM, Wm_t, DM, KARG(mem_norm_g) + DM, scr, r, lane);
        }
        {
            const float* xin = KARG(x); const float* min_ = KARG(mem);
            for (int m0 = gw; m0 < NTOK + BATCH * NMEM; m0 += 4 * NGW) {
                f32x4 v[4][4]; float ss_[4];
#pragma unroll
                for (int q = 0; q < 4; ++q) { const int m = m0 + q * NGW; ss_[q] = 0.f;
                    if (m < NTOK + BATCH * NMEM) { const f32x4* xr = (const f32x4*)(m < NTOK ? xin + (size_t)m * DM : min_ + (size_t)(m - NTOK) * DM) + lane;
#pragma unroll
                        for (int j = 0; j < 4; ++j) v[q][j] = xr[64 * j]; } }
#pragma unroll
                for (int q = 0; q < 4; ++q) { const int m = m0 + q * NGW;
                    if (m < NTOK + BATCH * NMEM) {
#pragma unroll
                        for (int j = 0; j < 4; ++j) ss_[q] += (v[q][j].x * v[q][j].x + v[q][j].y * v[q][j].y) + (v[q][j].z * v[q][j].z + v[q][j].w * v[q][j].w);
                        const float rstd = rsqrtf(wave_sum(ss_[q], lane) * (1.f / DM) + EPS);
                        bf16_t* orow = (m < NTOK) ? A0 + (size_t)(m / CTOK) * ((size_t)CTOK * BRW) + (size_t)(m % CTOK) * DM : memA + (size_t)(m - NTOK) * DM;
                        unsigned long long* o8 = (unsigned long long*)orow + lane;
#pragma unroll
                        for (int j = 0; j < 4; ++j) o8[64 * j] = (unsigned long long)pk2(v[q][j].x * rstd, v[q][j].y * rstd) | ((unsigned long long)pk2(v[q][j].z * rstd, v[q][j].w * rstd) << 32); } }
            }
        }
        for (int idx = bx * 512 + t0; idx < SEQ * 80; idx += G * 512) {
            const int t = idx / 80, i = idx % 80;
            if (i < 16) tabA[t * 16 + i] = cos_sin((double)t, 13.122363377404328  , (double)i / 16.0);
            else { const int k = i - 16, f = k & 31; tabB[t * 64 + k] = cos_sin((double)(k < 32 ? (t >> 6) : (t & 63)), 9.210340371976184  , (double)f / 32.0); }
        }
    }
#endif
    grid.sync();

#ifndef SKIP_PM
    {
        PHASE_PTRS();
        pg8::Gemm g2{launder(memA), launder(Wm_t), BATCH * NMEM, 2 * DM, DM}; pg8::StaticOrder S2; S2.init(BATCH * NMEM, 2 * DM, G, bx);
        EpiHead<1> E2{launder(MKV), nullptr, launder(KARG(mem_kn_g)), nullptr, nullptr, nullptr};
        pg8::gemm_phase(wave, lds3, g2, S2, E2);
    }
#endif
#pragma unroll 1
    for (int ch = 0; ch < NCH; ++ch) {
#ifndef SKIP_P1
#pragma unroll 1
        for (int rep = 0; rep < REP_P1; ++rep) {
            PHASE_PTRS();
            pg8::Gemm g{launder(A0 + (size_t)ch * CTOK * BRW), launder(Wa_t), CTOK, INA, DM}; pg8::StaticOrder S; S.init(CTOK, INA, G, bx, P1_WGM);
            EpiHead<0> E{launder(R), launder(KARG(qn_a)), launder(KARG(kn_a)), launder(KARG(mem_qn_g)), nullptr, launder(tabA)};
            pg8::gemm_phase(wave, lds3, g, S, E);
        }
#endif
        GRID_BAR();
#ifndef SKIP_P2
        {
            PHASE_PTRS();
            const bf16_t* QKV = launder(R + R_QKV / 2); const bf16_t* GATE = launder(R + R_GATE0 / 2); const bf16_t* QM = launder(R + R_QM0 / 2);
#ifdef PROBE_P2
#pragma unroll 1
            for (int rep2 = 0; rep2 < 2; ++rep2)
#endif
#pragma unroll 1
            for (int u = bx; u < 1536; u += G) {
                {
                    int bl, gg, h, qb;
                    if (u < 1024) { qb = u & 15; h = (u >> 4) & 7; gg = (u >> 7) & 1; bl = u >> 8; }
                    else { const int v = u - 1024; qb = v & 15; h = (v >> 4) & 7; bl = v >> 7; gg = 2; }
                    const int dl = 2 * gg, L = SEQ >> dl, i0g = qb * 256, res = i0g / L, i0 = i0g % L, NT = (L == 256) ? 4 : 6;
                    int ks = i0 - 64; if (ks < 0) ks = 0; if (ks > L - 64 * NT) ks = L - 64 * NT;
                    const size_t hb = (size_t)((bl * 3 + 0) * 3 + gg) * 8 + h;
                    const int dd = 1 << dl;
                    const bf16_t* Qp = QKV + (hb * 4096 + res + (size_t)i0 * dd) * 128;
                    const bf16_t* Kp = QKV + ((hb + 24) * 4096 + res + (size_t)ks * dd) * 128;
                    const bf16_t* Vp = QKV + ((hb + 48) * 4096 + res + (size_t)ks * dd) * 128;
                    att::EpiDil E{(bf16_t*)Qp, LSE + ((size_t)((bl * 3 + gg) * 8 + h)) * 4096 + res + i0 * dd, 128 * dd};
#ifdef PROBE_P2
                    if (rep2) { E.O = (bf16_t*)(dob + 96 * MiB); E.lse = (float*)(dob + 97 * MiB); }
#endif
                    att::attn_unit<true>(tid_now(wave), Qp, Kp, Vp, NT, ks - i0, (char*)lds, E, 128 * dd);
                }
            }
#pragma unroll 1
            for (int u = 1536 + bx; u < 1792; u += G) {
                {
                    const int v = u - 1536, qb = v & 15, mh = (v >> 4) & 3, bl = v >> 6, b = ch * CB + bl;
                    const bf16_t* Qp = QM + ((size_t)(bl * 4 + mh) * 4096 + qb * 256) * 128;
                    const bf16_t* Kp = MKV + (size_t)(((0 * 2 + 0) * 8 + b) * 4 + mh) * 256 * 128;
                    const bf16_t* Vp = MKV + (size_t)(((0 * 2 + 1) * 8 + b) * 4 + mh) * 256 * 128;
                    const size_t tl = (size_t)bl * 4096 + qb * 256;
                    att::EpiGate E{Y + ((size_t)ch * CTOK + tl) * BRW + 1024 + mh * 128, GATE + tl * BRW + 1024 + mh * 128};
                    att::attn_unit<false>(tid_now(wave), Qp, Kp, Vp, 4, 0, (char*)lds, E);
                }
            }
        }
#endif
        GRID_BAR();
#ifndef SKIP_P3
#pragma unroll 1
        for (int rep = 0; rep < REP_P3; ++rep) {
            PHASE_PTRS();
            const bf16_t* QKV = launder(R + R_QKV / 2); const bf16_t* GATE = launder(R + R_GATE0 / 2);
            const int t3 = tid_now(wave);
            for (int it = bx * 512 + t3; it < CTOK * 128; it += G * 512) {
                const int c = it & 15, h = (it >> 4) & 7, tl = it >> 7, bl = tl >> 12, t = tl & 4095;
                float ls[3]; bf16x8 ov[3];
#pragma unroll
                for (int gg = 0; gg < 3; ++gg) { const int p = t;
                    const size_t hb = (size_t)((bl * 3 + 0) * 3 + gg) * 8 + h;
                    ls[gg] = LSE[((size_t)((bl * 3 + gg) * 8 + h)) * 4096 + p];
                    ov[gg] = *(const bf16x8*)(QKV + (hb * 4096 + p) * 128 + c * 8); }
                const float mx = fmaxf(ls[0], fmaxf(ls[1], ls[2]));
                float w0 = __expf(ls[0] - mx), w1 = __expf(ls[1] - mx), w2 = __expf(ls[2] - mx); const float inv = 1.f / (w0 + w1 + w2); w0 *= inv; w1 *= inv; w2 *= inv;
                const bf16x8 gv = *(const bf16x8*)(GATE + (size_t)tl * BRW + h * 128 + c * 8);
                float r[8];
#pragma unroll
                for (int e = 0; e < 8; ++e) { const float o = w0 * bf2f((unsigned short)ov[0][e]) + w1 * bf2f((unsigned short)ov[1][e]) + w2 * bf2f((unsigned short)ov[2][e]);
                    r[e] = o * silu(bf2f((unsigned short)gv[e])); }
                u32x4 w; w.x = pk2(r[0], r[1]); w.y = pk2(r[2], r[3]); w.z = pk2(r[4], r[5]); w.w = pk2(r[6], r[7]);
                *(u32x4*)(Y + ((size_t)ch * CTOK + tl) * BRW + h * 128 + c * 8) = w;
            }
        }
#endif
        GRID_BAR();
    }

#ifndef SKIP_P4
#pragma unroll 1
    for (int rep = 0; rep < REP_P4; ++rep) {
        PHASE_PTRS();
        pg8::Gemm g{launder(Y), launder(Wo_t), NTOK, DM, BRW}; pg8::StaticOrder S; S.init(NTOK, DM, G, bx);
        EpiRes<true> E{launder(KARG(x)), launder(KARG(out)), launder(R + R_A1 / 2), launder(SS1)};
        pg8::gemm_phase(wave, lds3, g, S, E);
    }
#endif
    GRID_BAR();
#ifndef SKIP_P5
#pragma unroll 1
    for (int rep = 0; rep < REP_P5; ++rep) {
        PHASE_PTRS();
        pg8::Gemm g{launder(R + R_A1 / 2), launder(Wb_t), NTOK, INB, DM}; pg8::StaticOrder S; S.init(NTOK, INB, G, bx);
        EpiHead<2> E{launder(R), launder(KARG(qn_b)), launder(KARG(kn_b)), launder(KARG(mem_qn_g) + HD), launder(SS1), launder(tabB)};
        pg8::gemm_phase(wave, lds3, g, S, E);
    }
#endif
    GRID_BAR();
#ifndef SKIP_P6
#pragma unroll 1
    for (int rep = 0; rep < REP_P6; ++rep) {
        PHASE_PTRS();
        const bf16_t* Q1 = launder(R + R_Q1 / 2); const bf16_t* K1 = launder(R + R_K1 / 2); const bf16_t* V1 = launder(R + R_V1 / 2); const bf16_t* QM1 = launder(R + R_QM1 / 2); const bf16_t* GATE1 = launder(R + R_GATE1 / 2);
#pragma unroll 1
        for (int u = bx; u < 1024; u += G) {
            {
                int qb = u & 15, h = (u >> 4) & 7, b = u >> 7;
                if (G == 256) {
                    const int x = bx & 7, j = bx >> 3, r = u >> 8, pair = x + 8 * (r >> 1), idx = (r & 1) * 32 + j;
                    b = pair >> 1; h = (pair & 1) * 4 + (idx >> 4); qb = idx & 15; }
                const bf16_t* Qp = Q1 + ((size_t)(b * 8 + h) * 4096 + qb * 256) * 128;
                const bf16_t* Kp = K1 + (size_t)(b * 2 + (h >> 2)) * 4096 * 128;
                const bf16_t* Vp = V1 + (size_t)(b * 2 + (h >> 2)) * 4096 * 128;
                const size_t tl = (size_t)b * 4096 + qb * 256;
                att::EpiGate E{Y + tl * BRW + h * 128, GATE1 + tl * BRW + h * 128};
                att::attn_unit<false>(tid_now(wave), Qp, Kp, Vp, 64, 0, (char*)lds, E);
            }
        }
#pragma unroll 1
        for (int u = 1024 + bx; u < 1536; u += G) {
            {
                const int v = u - 1024, qb = v & 15, mh = (v >> 4) & 3, b = v >> 6;
                const bf16_t* Qp = QM1 + ((size_t)(b * 4 + mh) * 4096 + qb * 256) * 128;
                const bf16_t* Kp = MKV + (size_t)(((1 * 2 + 0) * 8 + b) * 4 + mh) * 256 * 128;
                const bf16_t* Vp = MKV + (size_t)(((1 * 2 + 1) * 8 + b) * 4 + mh) * 256 * 128;
                const size_t tl = (size_t)b * 4096 + qb * 256;
                att::EpiGate E{Y + tl * BRW + 1024 + mh * 128, GATE1 + tl * BRW + 1024 + mh * 128};
                att::attn_unit<false>(tid_now(wave), Qp, Kp, Vp, 4, 0, (char*)lds, E);
            }
        }
    }
#endif
    GRID_BAR();
#ifndef SKIP_P7
    {
        PHASE_PTRS();
        pg8::Gemm g{launder(Y), launder(Wo_t + (size_t)DM * BRW), NTOK, DM, BRW}; pg8::StaticOrder S; S.init(NTOK, DM, G, bx);
        EpiRes<false> E{launder(KARG(out)), launder(KARG(out)), nullptr, nullptr};
        pg8::gemm_phase(wave, lds3, g, S, E);
    }
#endif
#ifdef PROBE_SYNC
#pragma unroll 1
    for (int i = 0; i < PROBE_SYNC; ++i) GRID_BAR();
#endif
#ifdef PROBE_GEMM
    GRID_BAR();
    {
        PHASE_PTRS();
        pg8::Gemm g{launder(Y), launder(Wb_t), NTOK, INB, DM}; pg8::StaticOrder S; S.init(NTOK, INB, G, bx);
        EpiPlain E{launder(R), INB};
        pg8::gemm_phase(wave, lds3, g, S, E);
    }
#endif
}

extern "C" void kernel_launch(void* const* d_in, const int* in_sizes, int n_in, void* d_out, int out_size, void* d_ws, size_t ws_size, hipStream_t stream) {
    static int grid = 0;
    if (grid == 0) {
        if (n_in != 14 || out_size != NTOK * DM || ws_size < WS_END2) { fprintf(stderr, "kernel_launch: unexpected shapes (n_in %d out %d ws %zu)\n", n_in, out_size, ws_size); grid = -1; return; }
        int dev = 0, cus = 0, per_cu = 0;
        if (hipGetDevice(&dev) != hipSuccess || hipDeviceGetAttribute(&cus, hipDeviceAttributeMultiprocessorCount, dev) != hipSuccess) { grid = -1; return; }
        if (hipFuncSetAttribute((const void*)mega_fwd, hipFuncAttributeMaxDynamicSharedMemorySize, LDS_BYTES) != hipSuccess) { fprintf(stderr, "kernel_launch: hipFuncSetAttribute failed\n"); grid = -1; return; }
        if (hipOccupancyMaxActiveBlocksPerMultiprocessor(&per_cu, (const void*)mega_fwd, 512, LDS_BYTES) != hipSuccess || per_cu < 1) { fprintf(stderr, "kernel_launch: occupancy query says %d\n", per_cu); grid = -1; return; }
        grid = cus;
    }
    if (grid < 0) return;
    if (hipMemsetAsync((char*)d_ws + WS_BAR, 0, XCD_BAR_WORDS * 4, stream) != hipSuccess) { fprintf(stderr, "kernel_launch: memset failed\n"); return; }
    Params p{};
    p.x = (const float*)d_in[0]; p.mem = (const float*)d_in[1]; p.norm_g = (const float*)d_in[2]; p.mem_norm_g = (const float*)d_in[3];
    p.w_mem_kv = (const float*)d_in[4]; p.mem_qn_g = (const float*)d_in[5]; p.mem_kn_g = (const float*)d_in[6]; p.w_out = (const float*)d_in[7];
    p.w_in_a = (const float*)d_in[8]; p.qn_a = (const float*)d_in[9]; p.kn_a = (const float*)d_in[10]; p.w_in_b = (const float*)d_in[11];
    p.qn_b = (const float*)d_in[12]; p.kn_b = (const float*)d_in[13]; p.out = (float*)d_out; p.ws = (unsigned char*)d_ws;
    void* args[] = {&p};
    hipError_t e = hipLaunchCooperativeKernel((const void*)mega_fwd, dim3(grid), dim3(512), args, LDS_BYTES, stream);
    if (e != hipSuccess) fprintf(stderr, "cooperative launch failed: %s (grid %d)\n", hipGetErrorString(e), grid);
}
```

```cpp
#include <hip/hip_runtime.h>
#include <hip/hip_cooperative_groups.h>
#include <cstdio>
#include <cstdint>
#include <cmath>
#include <cstddef>
namespace cg = cooperative_groups;

#define LAS __attribute__((address_space(3)))
typedef unsigned short bf16_t;
typedef short bf16x8 __attribute__((ext_vector_type(8)));
typedef short s16x4 __attribute__((ext_vector_type(4)));
typedef float f32x4 __attribute__((ext_vector_type(4)));
typedef float f32x2 __attribute__((ext_vector_type(2)));
typedef float f32x16 __attribute__((ext_vector_type(16)));
typedef unsigned u32x4 __attribute__((ext_vector_type(4)));

constexpr int BATCH = 8, SEQ = 4096, DM = 1024, NTOK = BATCH * SEQ;
constexpr int HD = 128, NMEM = 256;
constexpr int INA = 11264, INB = 3584, BRW = 1536;
constexpr int NCH = 2, CB = BATCH / NCH, CTOK = CB * SEQ;
constexpr float EPS = 1e-6f;
constexpr float SCALE = 0.088388347648318440f;

constexpr size_t MiB = 1u << 20;
constexpr size_t WS_WB = 0, WS_WO = 8 * MiB, WS_WM = 14 * MiB, WS_MKV = 18 * MiB, WS_TABA = 26 * MiB, WS_TABB = 27 * MiB, WS_SS1 = 29 * MiB, WS_LSE = 31 * MiB;
constexpr size_t WS_BAR = 33 * MiB;
constexpr size_t WS_Y = 34 * MiB, WS_R = 130 * MiB, WS_END = 482 * MiB;
constexpr size_t R_QKV = 0, R_GATE0 = 288 * MiB, R_QM0 = 336 * MiB;
constexpr size_t R_A1 = 0, R_Q1 = 64 * MiB, R_K1 = 128 * MiB, R_V1 = 144 * MiB, R_QM1 = 160 * MiB, R_GATE1 = 192 * MiB;
constexpr size_t WS_WA = 482 * MiB, WS_MEMA = 505 * MiB, WS_END2 = 509 * MiB;

__device__ __forceinline__ unsigned f2bf(float f) { unsigned u = __builtin_bit_cast(unsigned, f); return (u + 0x7fffu + ((u >> 16) & 1u)) >> 16; }
__device__ __forceinline__ unsigned pk2(float lo, float hi) { return f2bf(lo) | (f2bf(hi) << 16); }
__device__ __forceinline__ float bf2f(unsigned short b) { return __uint_as_float(((unsigned)b) << 16); }
__device__ __forceinline__ unsigned cvt_pk_bf16(float lo, float hi) { unsigned r; asm volatile("v_cvt_pk_bf16_f32 %0, %1, %2" : "=v"(r) : "v"(lo), "v"(hi)); return r; }
__device__ __forceinline__ int tid_now(int wave_s) { int l; asm volatile("v_mbcnt_lo_u32_b32 %0, -1, 0\n\tv_mbcnt_hi_u32_b32 %0, -1, %0" : "=v"(l)); l = (wave_s << 6) | l; __builtin_assume(l >= 0 && l < 512); return l; }
template <class T> __device__ __forceinline__ T* as_global(T* p) { return (T*)(__attribute__((address_space(1))) T*)p; }
__device__ __forceinline__ float shfl_xor_l(float v, int m, int lane) { return __int_as_float(__builtin_amdgcn_ds_bpermute((lane ^ m) << 2, __float_as_int(v))); }
__device__ __forceinline__ float silu(float g) { return g / (1.f + __expf(-g)); }

namespace pg8 {
constexpr int BM = 256, BK = 64, HALF = 128, HTB = HALF * BK * 2, STAGE_BYTES = 8 * HTB, NXCD = 8, WGM = 8;
__host__ __device__ __forceinline__ int lds_byte(int r, int c) { const int st = (r >> 4) * 2 + (c >> 5), rr = r & 15, cc = c & 31, ob = rr * 64 + cc * 2; return st * 1024 + (ob ^ (((ob >> 9) & 1) << 5)); }
__host__ __device__ __forceinline__ void stage_rc(int b, int& R, int& C) { const int st = b / 1024, sb = b % 1024, swz = sb ^ (((sb >> 9) & 1) << 5); R = (st >> 1) * 16 + swz / 64; C = (st & 1) * 32 + (swz % 64) / 2; }
__host__ __device__ __forceinline__ int perm32(int rho) { const int n = rho >> 4, i = rho & 15; return 8 * (i >> 2) + 4 * n + (i & 3); }
struct Unit { int pm, pn; };
struct Gemm { const bf16_t* A; const bf16_t* Bt; int M, N, K; };
struct StaticOrder {
    int nM, nN, nwg, G, c, wgm;
    __host__ __device__ void init(int M, int N, int G_, int c_, int wgm_ = WGM) { nM = M / BM; nN = N / BM; nwg = nM * nN; G = G_; c = c_; wgm = wgm_; }
    __host__ __device__ bool next(int i, Unit& u) const {
        const long L = (long)i * G + c; if (L >= nwg) return false;
        int wgid = (int)L; { const int q = nwg / NXCD, r = nwg % NXCD, xcd = wgid % NXCD, off = wgid / NXCD; wgid = (xcd < r ? xcd * (q + 1) : r * (q + 1) + (xcd - r) * q) + off; }
        const int nig = wgm * nN, gid = wgid / nig, fm = gid * wgm, gsz = (nM - fm) < wgm ? (nM - fm) : wgm;
        u.pm = fm + ((wgid % nig) % gsz); u.pn = (wgid % nig) / gsz; return true;
    }
};

template <class Epi>
__device__ __forceinline__ void gemm_phase(const int wave_s, LAS unsigned char* lds, const Gemm g, const StaticOrder& S, const Epi& E) {
    const int tid = tid_now(wave_s);
    int wid = wave_s; asm volatile("" : "+s"(wid));
    const int lane = tid & 63, wr = wid >> 2, wc = wid & 3, fr = lane & 15, fq = lane >> 4;
    const int K = g.K, nt = K / BK;
    unsigned voffA[2], voffB[2];
#pragma unroll
    for (int i = 0; i < 2; ++i) { int R, C; stage_rc(tid * 16 + i * 8192, R, C); const int Rb = (R & ~31) + perm32(R & 31);
        voffA[i] = (unsigned)(R * K + C) * 2u; voffB[i] = (unsigned)(Rb * K + C) * 2u; }
    const size_t kstep = (size_t)(BK * 2);
    const size_t hstep = (size_t)HALF * K * 2;
    const size_t tstep = 2 * hstep;
    const unsigned ldsw = (unsigned)wid * 1024u;
    const int aoff = lds_byte(wr * 64 + fr, fq * 8), boff = lds_byte(wc * 32 + fr, fq * 8);
#define PG8_SA(b, h) (((b) * 2 + (h)) * HTB)
#define PG8_SB(b, h) ((4 + (b) * 2 + (h)) * HTB)
#define PG8_STAGE(bufoff, gbase, voff) do { _Pragma("unroll") for (int _i = 0; _i < 2; ++_i) \
        __builtin_amdgcn_global_load_lds((const unsigned*)((const char*)(gbase) + (voff)[_i]), (LAS unsigned*)(lds + (bufoff) + ldsw + _i * 8192), 16, 0, 0); } while (0)
#define PG8_LDA(dst, b, h) do { _Pragma("unroll") for (int m = 0; m < 4; ++m) _Pragma("unroll") for (int k = 0; k < 2; ++k) dst[m][k] = *(const LAS bf16x8*)(lds + PG8_SA(b, h) + aoff + m * 2048 + k * 1024); } while (0)
#define PG8_LDB(dst, b, h) do { _Pragma("unroll") for (int n = 0; n < 2; ++n) _Pragma("unroll") for (int k = 0; k < 2; ++k) dst[n][k] = *(const LAS bf16x8*)(lds + PG8_SB(b, h) + boff + n * 2048 + k * 1024); } while (0)
#define PG8_MMA(ai, bj, At, Bt) do { __builtin_amdgcn_s_setprio(1); _Pragma("unroll") for (int m = 0; m < 4; ++m) _Pragma("unroll") for (int n = 0; n < 2; ++n) _Pragma("unroll") for (int k = 0; k < 2; ++k) \
        acc[ai][bj][m][n] = __builtin_amdgcn_mfma_f32_16x16x32_bf16(Bt[n][k], At[m][k], acc[ai][bj][m][n], 0, 0, 0); __builtin_amdgcn_s_setprio(0); } while (0)
#define PG8_WAIT_V(n) asm volatile("s_waitcnt vmcnt(" #n ")" ::: "memory")
#define PG8_WAIT_L(n) asm volatile("s_waitcnt lgkmcnt(" #n ")" ::: "memory")
#define PG8_BAR __builtin_amdgcn_s_barrier()
#define PG8_SCHED __builtin_amdgcn_sched_barrier(0)
    Unit cur, nxt; int ui = 0;
    if (!S.next(0, cur)) return;
    f32x4 acc[2][2][4][2];
#pragma unroll
    for (int a = 0; a < 2; ++a)
#pragma unroll
        for (int b = 0; b < 2; ++b)
#pragma unroll
            for (int m = 0; m < 4; ++m)
#pragma unroll
                for (int n = 0; n < 2; ++n) acc[a][b][m][n] = (f32x4){0.f, 0.f, 0.f, 0.f};
    bf16x8 At[4][2], B0[2][2], B1[2][2];
    const char* cA = (const char*)g.A + (size_t)cur.pm * tstep; const char* cB = (const char*)g.Bt + (size_t)cur.pn * tstep;
    PG8_STAGE(PG8_SB(0, 0), cB, voffB); PG8_STAGE(PG8_SB(0, 1), cB + hstep, voffB); PG8_STAGE(PG8_SA(0, 0), cA, voffA); PG8_STAGE(PG8_SA(0, 1), cA + hstep, voffA);
    if (wr == 1) PG8_BAR;
    PG8_WAIT_V(2); PG8_BAR;
    PG8_STAGE(PG8_SB(1, 0), cB + kstep, voffB); PG8_STAGE(PG8_SA(1, 0), cA + kstep, voffA); PG8_STAGE(PG8_SB(1, 1), cB + hstep + kstep, voffB);
    PG8_WAIT_V(6); PG8_BAR;
    for (;;) {
        const bool has_next = S.next(ui + 1, nxt);
        const char* nA = has_next ? (const char*)g.A + (size_t)nxt.pm * tstep : cA; const char* nB = has_next ? (const char*)g.Bt + (size_t)nxt.pn * tstep : cB;
        for (int t = 0; t < nt; t += 2) {
            const bool last = (t == nt - 2);
            const char* a1 = cA + (size_t)(t + 1) * kstep;
            const char* a2 = last ? nA : cA + (size_t)(t + 2) * kstep; const char* b2 = last ? nB : cB + (size_t)(t + 2) * kstep;
            const char* a3 = a2 + kstep; const char* b3 = b2 + kstep;
            PG8_LDB(B0, 0, 0); PG8_LDB(B1, 0, 1); PG8_SCHED; PG8_LDA(At, 0, 0); PG8_STAGE(PG8_SA(1, 1), a1 + hstep, voffA);
            PG8_WAIT_V(8); PG8_WAIT_L(0); PG8_BAR; PG8_MMA(0, 0, At, B0); PG8_MMA(0, 1, At, B1); PG8_BAR; PG8_SCHED;
            PG8_LDA(At, 0, 1); PG8_STAGE(PG8_SB(0, 0), b2, voffB); PG8_STAGE(PG8_SB(0, 1), b2 + hstep, voffB); PG8_STAGE(PG8_SA(0, 0), a2, voffA);
            PG8_WAIT_V(8); PG8_WAIT_L(0); PG8_BAR; PG8_MMA(1, 0, At, B0); PG8_MMA(1, 1, At, B1); PG8_BAR; PG8_SCHED;
            PG8_LDB(B0, 1, 0); PG8_LDB(B1, 1, 1); PG8_SCHED; PG8_LDA(At, 1, 0); PG8_STAGE(PG8_SA(0, 1), a2 + hstep, voffA);
            PG8_WAIT_V(8); PG8_WAIT_L(0); PG8_BAR; PG8_MMA(0, 0, At, B0); PG8_MMA(0, 1, At, B1); PG8_BAR; PG8_SCHED;
            PG8_LDA(At, 1, 1); PG8_STAGE(PG8_SB(1, 0), b3, voffB); PG8_STAGE(PG8_SB(1, 1), b3 + hstep, voffB); PG8_STAGE(PG8_SA(1, 0), a3, voffA);
            PG8_WAIT_V(8); PG8_WAIT_L(0); PG8_BAR; PG8_MMA(1, 0, At, B0); PG8_MMA(1, 1, At, B1); PG8_BAR; PG8_SCHED;
        }
        if (wr == 0) PG8_BAR;
        E(acc, cur, wr, wc, fr, fq, (LAS float*)(lds + STAGE_BYTES));
        if (!has_next) break;
#pragma unroll
        for (int a = 0; a < 2; ++a)
#pragma unroll
            for (int b = 0; b < 2; ++b)
#pragma unroll
                for (int m = 0; m < 4; ++m)
#pragma unroll
                    for (int n = 0; n < 2; ++n) acc[a][b][m][n] = (f32x4){0.f, 0.f, 0.f, 0.f};
        cur = nxt; cA = nA; cB = nB; ++ui;
        if (wr == 1) PG8_BAR;
    }
    PG8_WAIT_V(0);
    PG8_BAR;
#undef PG8_SA
#undef PG8_SB
#undef PG8_STAGE
#undef PG8_LDA
#undef PG8_LDB
#undef PG8_MMA
#undef PG8_WAIT_V
#undef PG8_WAIT_L
#undef PG8_BAR
#undef PG8_SCHED
}
}

template <int KIND> struct EpiHead {
    bf16_t* R;
    const float* gq; const float* gk; const float* gm;
    const float* ss;
    const f32x2* tab;
    __device__ __forceinline__ void operator()(f32x4 (&acc)[2][2][4][2], const pg8::Unit& u, int wr, int wc, int fr, int fq, LAS float* xl) const {
        int ln_;
        { const int t_ = tid_now(wr * 4 + wc); fr = t_ & 15; fq = (t_ >> 4) & 3; ln_ = t_ & 63; }
        const int rloc = wr * 64 + fr;
        const int rbase = u.pm * 256 + rloc;
        const int pb = wc * 4 + fq;
        bool norm[2], rowmajor[2], qsc[2]; const float* g[2]; bf16_t* base[2]; int bs[2], gcol[2]; int rope = 0, dl = 0, sh = 12;
#pragma unroll
        for (int bj = 0; bj < 2; ++bj) {
            const int hd = u.pn * 2 + bj; norm[bj] = false; rowmajor[bj] = false; g[bj] = nullptr; base[bj] = R; bs[bj] = 0; gcol[bj] = 0;
            qsc[bj] = (KIND == 0) ? (hd < 24 || (hd >= 72 && hd < 76)) : (KIND == 2) ? (hd < 8 || (hd >= 12 && hd < 16)) : false;
            if (KIND == 0) {
                if (hd < 72) { const int tsel = hd / 24, gg = (hd >> 3) % 3, h = hd & 7; norm[bj] = tsel < 2; if (tsel < 2) rope = 1; g[bj] = (tsel == 0 ? gq : gk) + gg * 128;
                    dl = 2 * gg; bs[bj] = 3 * 3 * 8 * 4096; base[bj] = R + (R_QKV / 2) + (size_t)((tsel * 3 + gg) * 8 + h) * 4096 * 128; }
                else if (hd < 76) { norm[bj] = true; g[bj] = gm; bs[bj] = 4 * 4096; base[bj] = R + (R_QM0 / 2) + (size_t)(hd - 72) * 4096 * 128; }
                else { rowmajor[bj] = true; gcol[bj] = (hd - 76) * 128; base[bj] = R + (R_GATE0 / 2); }
            } else if (KIND == 2) {
                if (hd < 8) { norm[bj] = true; rope = 2; g[bj] = gq; bs[bj] = 8 * 4096; base[bj] = R + (R_Q1 / 2) + (size_t)hd * 4096 * 128; }
                else if (hd < 10) { norm[bj] = true; rope = 2; g[bj] = gk; bs[bj] = 2 * 4096; base[bj] = R + (R_K1 / 2) + (size_t)(hd - 8) * 4096 * 128; }
                else if (hd < 12) { bs[bj] = 2 * 4096; base[bj] = R + (R_V1 / 2) + (size_t)(hd - 10) * 4096 * 128; }
                else if (hd < 16) { norm[bj] = true; g[bj] = gm; bs[bj] = 4 * 4096; base[bj] = R + (R_QM1 / 2) + (size_t)(hd - 12) * 4096 * 128; }
                else { rowmajor[bj] = true; gcol[bj] = (hd - 16) * 128; base[bj] = R + (R_GATE1 / 2); }
            } else {
                const int layer = hd >> 3, tt = (hd >> 2) & 1, mh = hd & 3; norm[bj] = tt == 0; g[bj] = gk + layer * 128; sh = 8; bs[bj] = 4 * 256;
                base[bj] = R + (size_t)(((layer * 2 + tt) * 8) * 4 + mh) * 256 * 128;
            }
        }
        const bool anynorm = norm[0] || norm[1];
        if (anynorm) {
#pragma unroll
        for (int ai = 0; ai < 2; ++ai)
#pragma unroll
            for (int m = 0; m < 4; ++m)
#pragma unroll
                for (int bj = 0; bj < 2; ++bj) {
                    const f32x4 a = acc[ai][bj][m][0], b = acc[ai][bj][m][1];
                    float s = (a.x * a.x + a.y * a.y) + (a.z * a.z + a.w * a.w) + (b.x * b.x + b.y * b.y) + (b.z * b.z + b.w * b.w);
                    s += shfl_xor_l(s, 16, ln_); s += shfl_xor_l(s, 32, ln_);
                    if (fq == 0) xl[((ai * 128 + m * 16 + rloc) * 2 + bj) * 4 + wc] = s;
                }
        }
        const int np = (rope == 2) ? 64 : 16;
        const bool dorope = (rope == 2) || (rope == 1 && pb < 4);
        f32x4 tc0 = (f32x4){1.f, 0.f, 1.f, 0.f}, tc1 = tc0;
        if (dorope) { const f32x4* tp = as_global((const f32x4*)(tab + (size_t)(rbase & 4095) * np + 4 * pb)); tc0 = tp[0]; tc1 = tp[1]; }
        float fac[2][4][2];
#pragma unroll
        for (int ai = 0; ai < 2; ++ai)
#pragma unroll
            for (int m = 0; m < 4; ++m) {
                float r_ = 1.f;
                if (KIND == 2) { const f32x4 a = *(const f32x4*)(ss + (size_t)(rbase + ai * 128 + m * 16) * 4); r_ = rsqrtf(((a.x + a.y) + (a.z + a.w)) * (1.0f / 1024.0f) + EPS); }
                fac[ai][m][0] = r_; fac[ai][m][1] = r_;
            }
        if (anynorm) { asm volatile("s_waitcnt lgkmcnt(0)" ::: "memory"); __builtin_amdgcn_s_barrier(); asm volatile("" ::: "memory"); }
#pragma unroll
        for (int ai = 0; ai < 2; ++ai)
#pragma unroll
            for (int m = 0; m < 4; ++m)
#pragma unroll
                for (int bj = 0; bj < 2; ++bj)
                    if (norm[bj]) {
                        const f32x4 pp = *(const LAS f32x4*)(xl + ((ai * 128 + m * 16 + rloc) * 2 + bj) * 4);
                        const float r_ = fac[ai][m][bj];
                        fac[ai][m][bj] = r_ * rsqrtf(((pp.x + pp.y) + (pp.z + pp.w)) * (r_ * r_) * (1.0f / 128.0f) + EPS);
                    }
        int dlo = pb * 8, dhi = pb * 8 + 4;
        if (rope == 1 && pb < 4) { dlo = 4 * pb; dhi = 16 + 4 * pb; }
        if (rope == 2) { dlo = 4 * pb; dhi = 64 + 4 * pb; }
        f32x4 g0[2], g1[2];
#pragma unroll
        for (int bj = 0; bj < 2; ++bj) { g0[bj] = (f32x4){1.f, 1.f, 1.f, 1.f}; g1[bj] = g0[bj]; if (norm[bj]) { g0[bj] = *(const f32x4*)(g[bj] + dlo); g1[bj] = *(const f32x4*)(g[bj] + dhi); } }
#pragma unroll
        for (int ai = 0; ai < 2; ++ai)
#pragma unroll
            for (int m = 0; m < 4; ++m) {
                const int row = rbase + ai * 128 + m * 16, t = row & ((1 << sh) - 1);
                const f32x4 c01 = tc0, c23 = tc1;
                if (dorope && (ai * 4 + m) < 7) {
                    const int nrow = rbase + ((ai * 4 + m + 1) >> 2) * 128 + ((ai * 4 + m + 1) & 3) * 16;
                    const f32x4* tp = as_global((const f32x4*)(tab + (size_t)(nrow & 4095) * np + 4 * pb)); tc0 = tp[0]; tc1 = tp[1]; }
                const f32x4 cs = (f32x4){c01.x, c01.z, c23.x, c23.z}, sn = (f32x4){c01.y, c01.w, c23.y, c23.w};
                const int p = t;
#pragma unroll
                for (int bj = 0; bj < 2; ++bj) {
                    const float f = qsc[bj] ? fac[ai][m][bj] * (SCALE * 1.4426950408889634f) : fac[ai][m][bj];
                    f32x4 v0 = acc[ai][bj][m][0] * f * g0[bj], v1 = acc[ai][bj][m][1] * f * g1[bj];
                    if (dorope) { const f32x4 o0 = v0 * cs - v1 * sn, o1 = v1 * cs + v0 * sn; v0 = o0; v1 = o1; }
                    u32x4 w; w.x = cvt_pk_bf16(v0[0], v0[1]); w.y = cvt_pk_bf16(v0[2], v0[3]); w.z = cvt_pk_bf16(v1[0], v1[1]); w.w = cvt_pk_bf16(v1[2], v1[3]);
                    bf16_t* dst;
                    if (rowmajor[bj]) dst = base[bj] + (size_t)row * BRW + gcol[bj] + pb * 8;
                    else dst = base[bj] + ((size_t)(row >> sh) * bs[bj] + p) * 128 + pb * 8;
                    *(u32x4*)dst = w;
                }
                asm volatile("" ::: "memory");
            }
    }
};

struct EpiPlain {
    bf16_t* O; int ldc;
    __device__ __forceinline__ void operator()(f32x4 (&acc)[2][2][4][2], const pg8::Unit& u, int wr, int wc, int fr, int fq, LAS float* xl) const {
        { const int t_ = tid_now(wr * 4 + wc); fr = t_ & 15; fq = (t_ >> 4) & 3; }
        const int rbase = u.pm * 256 + wr * 64 + fr, cbase = u.pn * 256 + wc * 32 + 8 * fq;
#pragma unroll
        for (int ai = 0; ai < 2; ++ai)
#pragma unroll
            for (int m = 0; m < 4; ++m)
#pragma unroll
                for (int bj = 0; bj < 2; ++bj) { const f32x4 v0 = acc[ai][bj][m][0], v1 = acc[ai][bj][m][1];
                    u32x4 w; w.x = cvt_pk_bf16(v0[0], v0[1]); w.y = cvt_pk_bf16(v0[2], v0[3]); w.z = cvt_pk_bf16(v1[0], v1[1]); w.w = cvt_pk_bf16(v1[2], v1[3]);
                    *(u32x4*)(O + (size_t)(rbase + ai * 128 + m * 16) * ldc + cbase + bj * 128) = w; }
    }
};
template <bool FIRST> struct EpiRes {
    const float* xi; float* xo; bf16_t* A1; float* ss;
    __device__ __forceinline__ void operator()(f32x4 (&acc)[2][2][4][2], const pg8::Unit& u, int wr, int wc, int fr, int fq, LAS float* xl) const {
        int ln_;
        { const int t_ = tid_now(wr * 4 + wc); fr = t_ & 15; fq = (t_ >> 4) & 3; ln_ = t_ & 63; }
        const int rbase = u.pm * 256 + wr * 64 + fr, cbase = u.pn * 256 + wc * 32 + 8 * fq;
#pragma unroll
        for (int ai = 0; ai < 2; ++ai)
#pragma unroll
            for (int m = 0; m < 4; ++m) {
                const int row = rbase + ai * 128 + m * 16; float s = 0.f;
#pragma unroll
                for (int bj = 0; bj < 2; ++bj) {
                    const size_t off = (size_t)row * DM + cbase + bj * 128;
                    const f32x4 xa = *(const f32x4*)(xi + off), xb = *(const f32x4*)(xi + off + 4);
                    const f32x4 v0 = acc[ai][bj][m][0] + xa, v1 = acc[ai][bj][m][1] + xb;
                    *(f32x4*)(xo + off) = v0; *(f32x4*)(xo + off + 4) = v1;
                    if (FIRST) {
                        u32x4 w; w.x = cvt_pk_bf16(v0[0], v0[1]); w.y = cvt_pk_bf16(v0[2], v0[3]); w.z = cvt_pk_bf16(v1[0], v1[1]); w.w = cvt_pk_bf16(v1[2], v1[3]);
                        *(u32x4*)(A1 + off) = w;
                        s += (v0.x * v0.x + v0.y * v0.y) + (v0.z * v0.z + v0.w * v0.w) + (v1.x * v1.x + v1.y * v1.y) + (v1.z * v1.z + v1.w * v1.w);
                    }
                }
                if (FIRST) { s += shfl_xor_l(s, 16, ln_); s += shfl_xor_l(s, 32, ln_); if (fq == 0) xl[(ai * 128 + m * 16 + wr * 64 + fr) * 4 + wc] = s; }
                asm volatile("" ::: "memory");
            }
        if (FIRST) {
            asm volatile("s_waitcnt lgkmcnt(0)" ::: "memory"); __builtin_amdgcn_s_barrier(); asm volatile("" ::: "memory");
            if (wc == 0 && fq == 0) {
#pragma unroll
                for (int ai = 0; ai < 2; ++ai)
#pragma unroll
                    for (int m = 0; m < 4; ++m) { const f32x4 pp = *(const LAS f32x4*)(xl + (ai * 128 + m * 16 + wr * 64 + fr) * 4);
                        ss[(size_t)(rbase + ai * 128 + m * 16) * 4 + u.pn] = (pp.x + pp.y) + (pp.z + pp.w); }
            }
        }
    }
};

namespace att {
constexpr int D = 128, NW = 8, QBLK = 32, KVBLK = 64;
constexpr float THR = 8.f;
#ifndef ATT_SDEPTH
#define ATT_SDEPTH 2
#endif
constexpr int SDEPTH = ATT_SDEPTH;
constexpr size_t SHM_V = KVBLK * D * 2, SHM_K = KVBLK * D * 2, SHM_ATTN = 2 * SHM_V + 2 * SHM_K + NW * 64 * 4;
#define KSWZ(row, colB) ((row) * 256 + ((colB) ^ (((row) & 7) << 4)))
#define SBAR() __builtin_amdgcn_sched_barrier(0)
__device__ __forceinline__ int crow(int r, int hi) { return (r & 3) + 8 * (r >> 2) + 4 * hi; }
__device__ __forceinline__ unsigned cvtpk(float lo, float hi) { unsigned r; asm volatile("v_cvt_pk_bf16_f32 %0, %1, %2" : "=v"(r) : "v"(lo), "v"(hi)); return r; }
__device__ __forceinline__ void band_mask(f32x16& p0, f32x16& p1, int base) {
#pragma unroll
    for (int r = 0; r < 16; ++r) { const int c = (r & 3) + 8 * (r >> 2);
        if ((unsigned)(base + c + 64) > 128u) p0[r] = -INFINITY;
        if ((unsigned)(base + c + 32 + 64) > 128u) p1[r] = -INFINITY; }
}
__device__ __forceinline__ void partialSM(f32x16& p0, f32x16& p1, float& mhat, f32x16& negm, float& alpha) {
    constexpr float THR2 = THR * 1.4426950408889634f;
    float pmax = p0[0];
#pragma unroll
    for (int r = 1; r < 16; ++r) pmax = fmaxf(pmax, p0[r]);
#pragma unroll
    for (int r = 0; r < 16; ++r) pmax = fmaxf(pmax, p1[r]);
    { auto rr = __builtin_amdgcn_permlane32_swap(__float_as_uint(pmax), __float_as_uint(pmax), false, false);
      pmax = fmaxf(__uint_as_float(rr[0]), __uint_as_float(rr[1])); }
    if (__builtin_expect(__all(pmax <= THR2), 1)) { alpha = 1.f; }
    else { const float dl = fmaxf(pmax, 0.f); mhat += dl; alpha = __builtin_amdgcn_exp2f(-dl);
#pragma unroll
        for (int r = 0; r < 16; ++r) { p0[r] -= dl; p1[r] -= dl; }
#pragma unroll
        for (int r = 0; r < 16; ++r) negm[r] = -mhat; }
#pragma unroll
    for (int r = 0; r < 16; ++r) p0[r] = __builtin_amdgcn_exp2f(p0[r]);
}
__device__ __forceinline__ void finishSM(f32x16& p0, f32x16& p1, float alpha, float& l_reg, bf16x8& pa0, bf16x8& pa1, bf16x8& pa2, bf16x8& pa3) {
#pragma unroll
    for (int r = 0; r < 16; ++r) p1[r] = __builtin_amdgcn_exp2f(p1[r]);
    float ps = 0;
#pragma unroll
    for (int r = 0; r < 16; ++r) ps += p0[r];
#pragma unroll
    for (int r = 0; r < 16; ++r) ps += p1[r];
    { auto rr = __builtin_amdgcn_permlane32_swap(__float_as_uint(ps), __float_as_uint(ps), false, false);
      ps = __uint_as_float(rr[0]) + __uint_as_float(rr[1]); }
    l_reg = l_reg * alpha + ps;
#define PK4(P, BASE, OUT) do { unsigned a0 = cvtpk(P[BASE + 0], P[BASE + 1]), a1 = cvtpk(P[BASE + 2], P[BASE + 3]);   \
    unsigned b0 = cvtpk(P[BASE + 4], P[BASE + 5]), b1 = cvtpk(P[BASE + 6], P[BASE + 7]);                              \
    auto r0 = __builtin_amdgcn_permlane32_swap(a0, b0, false, false); auto r1 = __builtin_amdgcn_permlane32_swap(a1, b1, false, false); \
    u32x4 w = {r0[0], r1[0], r0[1], r1[1]}; OUT = *reinterpret_cast<bf16x8*>(&w); } while (0)
    PK4(p0, 0, pa0); PK4(p0, 8, pa1); PK4(p1, 0, pa2); PK4(p1, 8, pa3);
#undef PK4
}
__device__ __forceinline__ void qkt(f32x16& p0, f32x16& p1, const bf16_t* Ks, const bf16x8* qr, const f32x16& negm, int r32, int hi) {
#pragma unroll
    for (int d0 = 0; d0 < 8; ++d0) { int cb = (d0 * 16 + hi * 8) * 2;
        bf16x8 b0 = *reinterpret_cast<const bf16x8*>((const char*)Ks + KSWZ(r32, cb));
        bf16x8 b1 = *reinterpret_cast<const bf16x8*>((const char*)Ks + KSWZ(32 + r32, cb));
        if (d0 == 0) { p0 = __builtin_amdgcn_mfma_f32_32x32x16_bf16(b0, qr[0], negm, 0, 0, 0); p1 = __builtin_amdgcn_mfma_f32_32x32x16_bf16(b1, qr[0], negm, 0, 0, 0); }
        else { p0 = __builtin_amdgcn_mfma_f32_32x32x16_bf16(b0, qr[d0], p0, 0, 0, 0); p1 = __builtin_amdgcn_mfma_f32_32x32x16_bf16(b1, qr[d0], p1, 0, 0, 0); } }
}
__device__ __forceinline__ int v_st(int k, int c) { const int kk = (k & ~0xC) | ((k & 4) << 1) | ((k & 8) >> 1); return ((kk >> 3) * 4 + (c >> 5)) * 512 + ((kk & 7) * 32 + (c & 31)) * 2; }
__device__ __forceinline__ int v_rd_base(int lane) { return ((lane & 3) << 3) | (((lane >> 2) & 3) << 6) | (((lane >> 4) & 1) << 5) | (((lane >> 5) & 1) << 8); }
constexpr int v_rd_off(int d0, int ks, int half) { return d0 * 512 + ks * 4096 + half * 2048; }
template <int OFF> __device__ __forceinline__ s16x4 tr_read(int vb) {
    s16x4 r; asm volatile("ds_read_b64_tr_b16 %0, %1 offset:%2" : "=&v"(r) : "v"(vb), "i"(OFF) : "memory"); return r;
}
template <int D0> __device__ __forceinline__ void pv_one(f32x16& od, int vb, bf16x8 pa0, bf16x8 pa1, bf16x8 pa2, bf16x8 pa3) {
    const s16x4 l0 = tr_read<v_rd_off(D0, 0, 0)>(vb), h0 = tr_read<v_rd_off(D0, 0, 1)>(vb), l1 = tr_read<v_rd_off(D0, 1, 0)>(vb), h1 = tr_read<v_rd_off(D0, 1, 1)>(vb);
    const s16x4 l2 = tr_read<v_rd_off(D0, 2, 0)>(vb), h2 = tr_read<v_rd_off(D0, 2, 1)>(vb), l3 = tr_read<v_rd_off(D0, 3, 0)>(vb), h3 = tr_read<v_rd_off(D0, 3, 1)>(vb);
    asm volatile("s_waitcnt lgkmcnt(0)" ::: "memory"); SBAR();
#define PK(L, H) (bf16x8){L[0], L[1], L[2], L[3], H[0], H[1], H[2], H[3]}
    od = __builtin_amdgcn_mfma_f32_32x32x16_bf16(pa0, PK(l0, h0), od, 0, 0, 0);
    od = __builtin_amdgcn_mfma_f32_32x32x16_bf16(pa1, PK(l1, h1), od, 0, 0, 0);
    od = __builtin_amdgcn_mfma_f32_32x32x16_bf16(pa2, PK(l2, h2), od, 0, 0, 0);
    od = __builtin_amdgcn_mfma_f32_32x32x16_bf16(pa3, PK(l3, h3), od, 0, 0, 0);
#undef PK
}
__device__ __forceinline__ void pv_d0(f32x16* o, int vb, bf16x8 pa0, bf16x8 pa1, bf16x8 pa2, bf16x8 pa3) {
    pv_one<0>(o[0], vb, pa0, pa1, pa2, pa3); pv_one<1>(o[1], vb, pa0, pa1, pa2, pa3); pv_one<2>(o[2], vb, pa0, pa1, pa2, pa3); pv_one<3>(o[3], vb, pa0, pa1, pa2, pa3);
}

constexpr int STG_ROW = 136;
constexpr int STG_WAVE = 32 * STG_ROW * 2;
__device__ __forceinline__ void stage_o(const f32x16* o, const float* rli, bf16_t* stg, int r32, int hi) {
#pragma unroll
    for (int r = 0; r < 16; ++r) { const int orow = crow(r, hi);
#pragma unroll
        for (int d0 = 0; d0 < 4; ++d0) stg[orow * STG_ROW + d0 * 32 + r32] = (bf16_t)f2bf(o[d0][r] * rli[r]); }
    asm volatile("s_waitcnt lgkmcnt(0)" ::: "memory");
}
struct EpiDil {
    bf16_t* O; float* lse; int RS;
    __device__ __forceinline__ void operator()(const f32x16* o, const float* rli, float l_reg, float m_reg, int wid, int lane, bf16_t* stg) const {
        asm volatile("" : "+v"(lane)); __builtin_assume(lane >= 0 && lane < 64);
        const int r32 = lane & 31, hi = lane >> 5;
        stage_o(o, rli, stg, r32, hi);
        bf16_t* Ow = O + (size_t)(wid * QBLK) * RS;
#pragma unroll
        for (int i = 0; i < 8; ++i) { const int row = i * 4 + (lane >> 4), ch = lane & 15;
            const u32x4 v = *(const u32x4*)(stg + row * STG_ROW + ch * 8); *(u32x4*)(Ow + (size_t)row * RS + ch * 8) = v; }
        if (hi == 0) lse[(wid * QBLK + r32) * (RS >> 7)] = (m_reg + __log2f(l_reg)) * 0.6931471805599453f;
    }
};
struct EpiGate {
    bf16_t* Y; const bf16_t* G;
    __device__ __forceinline__ void operator()(const f32x16* o, const float* rli, float l_reg, float m_reg, int wid, int lane, bf16_t* stg) const {
        asm volatile("" : "+v"(lane)); __builtin_assume(lane >= 0 && lane < 64);
        const int r32 = lane & 31, hi = lane >> 5;
        stage_o(o, rli, stg, r32, hi);
#pragma unroll
        for (int i = 0; i < 8; ++i) { const int row = i * 4 + (lane >> 4), ch = lane & 15; const size_t idx = (size_t)(wid * QBLK + row) * BRW + ch * 8;
            const bf16x8 gv = *(const bf16x8*)(G + idx); const bf16x8 ov = *(const bf16x8*)(stg + row * STG_ROW + ch * 8);
            float rr[8];
#pragma unroll
            for (int e = 0; e < 8; ++e) rr[e] = bf2f((unsigned short)ov[e]) * silu(bf2f((unsigned short)gv[e]));
            u32x4 w; w.x = pk2(rr[0], rr[1]); w.y = pk2(rr[2], rr[3]); w.z = pk2(rr[4], rr[5]); w.w = pk2(rr[6], rr[7]);
            *(u32x4*)(Y + idx) = w; }
    }
};

__device__ __forceinline__ void glds16s(unsigned voff, const void* sbase, unsigned lds_dst) { unsigned keep;
    asm volatile("s_mov_b32 %0, m0\n\ts_mov_b32 m0, %3\n\ts_nop 0\n\tglobal_load_lds_dwordx4 %1, %2\n\ts_mov_b32 m0, %0" : "=&s"(keep) : "v"(voff), "s"(sbase), "s"(lds_dst) : "memory"); }

template <bool MASK, class Epi>
__device__ __forceinline__ void attn_unit(const int tid, const bf16_t* Qb, const bf16_t* Kh, const bf16_t* Vh, int NT, int dq, char* lds, const Epi& E, const int rs_arg = D) {
    const int RS = MASK ? rs_arg : D;
    const int wid = __builtin_amdgcn_readfirstlane(tid >> 6), lane = tid & 63, r32 = lane & 31, hi = lane >> 5;
    constexpr int NSLOT = 4;
    bf16_t* V_lds = (bf16_t*)lds; bf16_t* K_lds = (bf16_t*)(lds + NSLOT * SHM_V);
    float* ws = (float*)(lds + NSLOT * SHM_V + NSLOT * SHM_K) + wid * 64; float* li_l = ws; float* al_l = ws + 32;
    float m_reg = 0.f, l_reg = 0; f32x16 o[4] = {}; bf16x8 qr[8];
    f32x16 negm = f32x16{};
    const bf16_t* Qw = Qb + (long)(wid * QBLK + r32) * RS + hi * 8;
#pragma unroll
    for (int d0 = 0; d0 < 8; ++d0) qr[d0] = *reinterpret_cast<const bf16x8*>(Qw + d0 * 16);
    const int vb0 = (int)(uintptr_t)V_lds + v_rd_base(lane);
    const int mb0 = dq + 4 * hi - (wid * QBLK + r32);
    unsigned kof[2], vof[2];
#pragma unroll
    for (int i = 0; i < 2; ++i) { const int p = wid * 2 + i;
        const int krow = p * 4 + (lane >> 4), kc = (lane & 15) ^ (krow & 7); kof[i] = (unsigned)(krow * RS * 2 + kc * 16);
        const int sub = p * 2 + (lane >> 5), kk = (sub >> 2) * 8 + ((lane & 31) >> 2), k = (kk & ~0xC) | ((kk & 4) << 1) | ((kk & 8) >> 1), c = (sub & 3) * 32 + 8 * (lane & 3);
        vof[i] = (unsigned)(k * RS * 2 + c * 2); }
    const unsigned ldsV = (unsigned)(uintptr_t)V_lds + (unsigned)wid * 2048u, ldsK = (unsigned)(uintptr_t)K_lds + (unsigned)wid * 2048u;
#define DMA_TILE(t, slot) do { const char* kt_ = (const char*)(Kh + (long)(t) * KVBLK * RS); const char* vt_ = (const char*)(Vh + (long)(t) * KVBLK * RS); \
    const unsigned so_ = (unsigned)(slot) * (unsigned)SHM_V; \
    glds16s(kof[0], kt_, (unsigned)__builtin_amdgcn_readfirstlane(ldsK + so_)); glds16s(kof[1], kt_, (unsigned)__builtin_amdgcn_readfirstlane(ldsK + so_ + 1024u)); \
    glds16s(vof[0], vt_, (unsigned)__builtin_amdgcn_readfirstlane(ldsV + so_)); glds16s(vof[1], vt_, (unsigned)__builtin_amdgcn_readfirstlane(ldsV + so_ + 1024u)); } while (0)
#define WAIT_BAR(N) do { asm volatile("s_waitcnt vmcnt(" #N ")" ::: "memory"); __syncthreads(); } while (0)
#define RESC(a) do { if (__any((a) < 1.f)) { if (hi == 0) al_l[r32] = (a); asm volatile("s_waitcnt lgkmcnt(0)" ::: "memory"); \
    _Pragma("unroll") for (int d = 0; d < 4; ++d) _Pragma("unroll") for (int r = 0; r < 16; ++r) o[d][r] *= al_l[crow(r, hi)]; } } while (0)
#define MSK(P0, P1, t) do { if (MASK) band_mask(P0, P1, mb0 + (t) * KVBLK); } while (0)
    f32x16 pA0, pA1, pB0, pB1; float mnA, mnB, alA, alB; bf16x8 pa0, pa1, pa2, pa3;
    const int widu = wid;
    if (widu >= 4) __builtin_amdgcn_s_setprio(1);
#define ACT(t) (!MASK || ((dq + (t) * KVBLK + 127 >= widu * QBLK) && (dq + (t) * KVBLK <= widu * QBLK + 95)))
    bool aA, aB;
    DMA_TILE(0, 0); DMA_TILE(1, 1); DMA_TILE(2, 2);
    WAIT_BAR(8);
    aA = ACT(0);
    if (aA) { qkt(pA0, pA1, K_lds, qr, negm, r32, hi); MSK(pA0, pA1, 0); partialSM(pA0, pA1, m_reg, negm, alA); } else alA = 1.f;
    RESC(alA);
    WAIT_BAR(4);
    int sc_ = 1, sp_ = 0, sn_ = 2, sf_ = 3;
#define STEP(PC0, PC1, PP0, PP1, aC, aP, alC, alP, mnC, t) do { \
        const bool more_ = (t) + 2 < NT; if (more_) DMA_TILE((t) + 2, sf_); \
        aC = ACT(t); \
        SBAR(); if (aC) { qkt(PC0, PC1, (bf16_t*)((char*)K_lds + sc_ * SHM_K), qr, negm, r32, hi); MSK(PC0, PC1, t); } \
        if (aP) finishSM(PP0, PP1, alP, l_reg, pa0, pa1, pa2, pa3); SBAR(); \
        if (aP) pv_d0(o, vb0 + sp_ * (int)SHM_V, pa0, pa1, pa2, pa3); \
        if (aC) partialSM(PC0, PC1, m_reg, negm, alC); else alC = 1.f; \
        RESC(alC); \
        if (more_) { WAIT_BAR(4); } else { WAIT_BAR(0); }           \
        { const int t_ = sp_; sp_ = sc_; sc_ = sn_; sn_ = sf_; sf_ = t_; } } while (0)
    int j = 1;
    for (; j + 1 < NT; j += 2) {
        STEP(pB0, pB1, pA0, pA1, aB, aA, alB, alA, mnB, j);
        STEP(pA0, pA1, pB0, pB1, aA, aB, alA, alB, mnA, j + 1);
    }
    aB = ACT(NT - 1);
    SBAR(); if (aB) { qkt(pB0, pB1, (bf16_t*)((char*)K_lds + sc_ * SHM_K), qr, negm, r32, hi); MSK(pB0, pB1, NT - 1); }
    if (aA) finishSM(pA0, pA1, alA, l_reg, pa0, pa1, pa2, pa3); SBAR();
    if (aA) pv_d0(o, vb0 + sp_ * (int)SHM_V, pa0, pa1, pa2, pa3);
    if (aB) partialSM(pB0, pB1, m_reg, negm, alB); else alB = 1.f;
    RESC(alB);
    if (aB) { finishSM(pB0, pB1, alB, l_reg, pa0, pa1, pa2, pa3); SBAR();
        pv_d0(o, vb0 + sc_ * (int)SHM_V, pa0, pa1, pa2, pa3); }
#undef ACT
#undef STEP
    if (hi == 0) li_l[r32] = l_reg; asm volatile("s_waitcnt lgkmcnt(0)" ::: "memory");
    float rli[16];
#pragma unroll
    for (int r = 0; r < 16; ++r) rli[r] = __builtin_amdgcn_rcpf(li_l[crow(r, hi)]);
    __builtin_amdgcn_s_setprio(0);
    __syncthreads();
    E(o, rli, l_reg, m_reg, wid, lane, (bf16_t*)(lds + wid * STG_WAVE));
    __syncthreads();
#undef DMA_TILE
#undef WAIT_BAR
#undef RESC
#undef MSK
}
}

#define XB_TMO      128
#define XB_XCNT(j)  (256  + 64 * (j))
#define XB_XSUB(j)  (1280 + 64 * (j))
#define XB_XGEN(j)  (2304 + 64 * (j))
#define XB_TOP      3328
#define XB_TOPGEN   3392
#define XCD_BAR_WORDS 3456
#define XB_SPIN_CAP (1u << 18)
__device__ __forceinline__ unsigned xb_ld(unsigned* p)              { return __hip_atomic_load(p, __ATOMIC_RELAXED, __HIP_MEMORY_SCOPE_AGENT); }
__device__ __forceinline__ unsigned xb_add(unsigned* p, unsigned v) { return __hip_atomic_fetch_add(p, v, __ATOMIC_RELAXED, __HIP_MEMORY_SCOPE_AGENT); }
__device__ __forceinline__ unsigned xb_xcc_id() { return (unsigned)__builtin_amdgcn_s_getreg((3 << 11) | 20) & 0xFu; }
#define XB_SPIN(cond, bar) do { unsigned _sp = 0; while (cond) { __builtin_amdgcn_s_sleep(1); \
    if ((++_sp & 255u) == 0u) { if (xb_ld(&(bar)[XB_TMO])) break; if (_sp > XB_SPIN_CAP) { atomicAdd(&(bar)[XB_TMO], 1u); break; } } } } while (0)
struct XcdBarrier { unsigned* bar; unsigned x; volatile LAS unsigned* st; };
__device__ __forceinline__ XcdBarrier xcd_barrier_post(unsigned* bar, volatile LAS unsigned* st) {
    XcdBarrier b; b.bar = bar; b.x = xb_xcc_id(); b.st = st;
    if (threadIdx.x == 0) (void)xb_add(&bar[XB_XCNT(b.x)], 1u);
    return b;
}
__device__ __forceinline__ void xcd_barrier_complete(unsigned* bar, unsigned x, unsigned& nloc, unsigned& nx) {
    const unsigned G = gridDim.x * gridDim.y * gridDim.z;
    unsigned sum, cnt, mine, sp = 0u;
    for (;;) {
        sum = 0u; cnt = 0u; mine = 0u;
#pragma unroll
        for (unsigned j = 0; j < 16; ++j) { const unsigned c = xb_ld(&bar[XB_XCNT(j)]); sum += c; cnt += (c > 0u) ? 1u : 0u; mine = (j == x) ? c : mine; }
        if (sum == G) break;
        __builtin_amdgcn_s_sleep(1);
        if ((++sp & 255u) == 0u) { if (xb_ld(&bar[XB_TMO])) break; if (sp > XB_SPIN_CAP) { atomicAdd(&bar[XB_TMO], 1u); break; } }
    }
    nloc = mine > 0u ? mine : 1u; nx = cnt > 0u ? cnt : 1u;
}
__device__ __forceinline__ void xcd_barrier(const XcdBarrier& b, const int wave_s) {
    asm volatile("s_waitcnt vmcnt(0)" ::: "memory");
    __syncthreads();
    if (tid_now(wave_s) == 0) {
        unsigned* bar = b.bar;
        __builtin_amdgcn_s_waitcnt(0);
        unsigned nloc = b.st[0], nx = b.st[1];
        if (nloc == 0u) { xcd_barrier_complete(bar, b.x, nloc, nx); b.st[0] = nloc; b.st[1] = nx; }
        const unsigned old = xb_add(&bar[XB_XSUB(b.x)], 1u);
        const unsigned gen = old / nloc;
        if (old + 1u == (gen + 1u) * nloc) {
            __builtin_amdgcn_fence(__ATOMIC_RELEASE, "agent");
            asm volatile("s_waitcnt vmcnt(0)" ::: "memory");
            const unsigned og = xb_add(&bar[XB_TOP], 1u);
            const unsigned tg = og / nx;
            if (og + 1u == (tg + 1u) * nx) xb_add(&bar[XB_TOPGEN], 1u);
            else XB_SPIN(xb_ld(&bar[XB_TOPGEN]) == tg, bar);
            __builtin_amdgcn_fence(__ATOMIC_ACQUIRE, "agent");
            xb_add(&bar[XB_XGEN(b.x)], 1u);
            asm volatile("s_waitcnt vmcnt(0)" ::: "memory");
        } else {
            XB_SPIN(xb_ld(&bar[XB_XGEN(b.x)]) == gen, bar);
            __builtin_amdgcn_fence(__ATOMIC_ACQUIRE, "agent");
            asm volatile("s_waitcnt vmcnt(0)" ::: "memory");
        }
    }
    __syncthreads();
}

__device__ __forceinline__ float wave_sum(float v, int lane) {
#pragma unroll
    for (int o = 1; o < 64; o <<= 1) v += shfl_xor_l(v, o, lane);
    return v;
}
template <int PERMK> __device__ __forceinline__ int srccol(int n) {
    if (PERMK == 0) return n;
    const int hd = n >> 7, p = n & 127, pb = p >> 3, nn = (p >> 2) & 1, j = p & 3;
    if (PERMK == 1) { if (hd < 48 && p < 32) return hd * 128 + 4 * pb + j + 16 * nn; return n; }
    if (hd < 10) return hd * 128 + 4 * pb + j + 64 * nn; return n;
}
template <int PERMK>
__device__ __forceinline__ void transpose_item(const float* W, int K, int N, bf16_t* WT, int row_off, const float* gk, LAS float* scr, int item, int lane) {
    const int nblk = N / 32, kb = item / nblk, nb = item % nblk, k0 = 64 * kb, n0 = 32 * nb;
    const int src = srccol<PERMK>(n0 + 4 * (lane & 7));
#pragma unroll
    for (int i = 0; i < 8; ++i) { const int kk = 8 * i + (lane >> 3); f32x4 v = *(const f32x4*)(W + (size_t)(k0 + kk) * N + src); if (gk) v = v * gk[k0 + kk];
        LAS float* d = scr + kk * 33 + 4 * (lane & 7); d[0] = v.x; d[1] = v.y; d[2] = v.z; d[3] = v.w; }
    asm volatile("s_waitcnt lgkmcnt(0)" ::: "memory");
    const int c = lane & 7;
#pragma unroll
    for (int j = 0; j < 4; ++j) { const int n = (lane >> 3) + 8 * j; const LAS float* s = scr + (8 * c) * 33 + n;
        u32x4 o; o.x = pk2(s[0 * 33], s[1 * 33]); o.y = pk2(s[2 * 33], s[3 * 33]); o.z = pk2(s[4 * 33], s[5 * 33]); o.w = pk2(s[6 * 33], s[7 * 33]);
        *(u32x4*)(WT + (size_t)(row_off + n0 + n) * K + k0 + 8 * c) = o; }
    asm volatile("s_waitcnt lgkmcnt(0)" ::: "memory");
}
__device__ __forceinline__ void rms_row_to_bf16(const float* xrow, bf16_t* orow, int lane) {
    const f32x4* xr = (const f32x4*)xrow + lane;
    f32x4 v[4]; float s = 0.f;
#pragma unroll
    for (int j = 0; j < 4; ++j) { v[j] = xr[64 * j]; s += (v[j].x * v[j].x + v[j].y * v[j].y) + (v[j].z * v[j].z + v[j].w * v[j].w); }
    const float rstd = rsqrtf(wave_sum(s, lane) * (1.f / DM) + EPS);
    unsigned long long* o8 = (unsigned long long*)orow + lane;
#pragma unroll
    for (int j = 0; j < 4; ++j) o8[64 * j] = (unsigned long long)pk2(v[j].x * rstd, v[j].y * rstd) | ((unsigned long long)pk2(v[j].z * rstd, v[j].w * rstd) << 32);
}
__device__ __forceinline__ f32x2 cos_sin(double pos, double lntheta, double e) {
    const double ang = pos * exp(-e * lntheta);
    const double rev = ang * 0.15915494309189533577;
    const float fr = (float)(rev - rint(rev));
    return (f32x2){__builtin_amdgcn_cosf(fr), __builtin_amdgcn_sinf(fr)};
}

typedef const __attribute__((address_space(4))) unsigned char* kptr_t;
__device__ __forceinline__ kptr_t kargs() { kptr_t p = (kptr_t)__builtin_amdgcn_kernarg_segment_ptr(); asm volatile("" : "+s"(p)); return p; }
#define KARG(field) as_global(*(decltype(Params::field) const __attribute__((address_space(4)))*)(kb + offsetof(Params, field)))
#define PHASE_PTRS() kptr_t kb = kargs(); unsigned char* ws = KARG(ws); unsigned char* dob = (unsigned char*)KARG(out); \
    bf16_t* Wb_t = (bf16_t*)(ws + WS_WB); bf16_t* Wo_t = (bf16_t*)(ws + WS_WO); bf16_t* Wm_t = (bf16_t*)(ws + WS_WM); bf16_t* MKV = (bf16_t*)(ws + WS_MKV); \
    f32x2* tabA = (f32x2*)(ws + WS_TABA); f32x2* tabB = (f32x2*)(ws + WS_TABB); float* SS1 = (float*)(ws + WS_SS1); float* LSE = (float*)(ws + WS_LSE); \
    bf16_t* Y = (bf16_t*)(ws + WS_Y); bf16_t* R = (bf16_t*)(ws + WS_R); \
    bf16_t* A0 = (bf16_t*)(ws + WS_Y); bf16_t* Wa_t = (bf16_t*)(ws + WS_WA); bf16_t* memA = (bf16_t*)(ws + WS_MEMA); \
    (void)Wb_t; (void)Wo_t; (void)Wm_t; (void)MKV; (void)tabA; (void)tabB; (void)SS1; (void)LSE; (void)Y; (void)R; (void)A0; (void)Wa_t; (void)memA
template <class T> __device__ __forceinline__ T* launder(T* p) { __attribute__((address_space(1))) T* g_ = (__attribute__((address_space(1))) T*)p; asm volatile("" : "+s"(g_)); return (T*)g_; }
struct Params {
    const float *x, *mem, *norm_g, *mem_norm_g, *w_mem_kv, *mem_qn_g, *mem_kn_g, *w_out, *w_in_a, *qn_a, *kn_a, *w_in_b, *qn_b, *kn_b;
    float* out; unsigned char* ws;
};
constexpr int LDS_BYTES = 147456;

__global__ void __launch_bounds__(512) mega_fwd(Params P) {
    extern __shared__ __attribute__((aligned(16))) unsigned char lds[];
    cg::grid_group grid = cg::this_grid();
    LAS unsigned char* lds3 = (LAS unsigned char*)lds;
    const int tid = threadIdx.x, lane = tid & 63, wave = __builtin_amdgcn_readfirstlane(tid >> 6);
    const int G = gridDim.x, bx = blockIdx.x;
    volatile LAS unsigned* MISC = (volatile LAS unsigned*)(lds3 + LDS_BYTES - 64);
    if (tid < 16) MISC[tid] = 0u;
    __syncthreads();
    { kptr_t kb = kargs(); (void)xcd_barrier_post((unsigned*)(KARG(ws) + WS_BAR), MISC); }
#define GRID_BAR() do { kptr_t kb = kargs(); XcdBarrier b_; b_.bar = (unsigned*)(KARG(ws) + WS_BAR); b_.x = xb_xcc_id(); b_.st = (volatile LAS unsigned*)(lds3 + LDS_BYTES - 64); xcd_barrier(b_, wave); } while (0)
#ifndef P1_WGM
#define P1_WGM 8
#endif
#ifndef REP_P0
#define REP_P0 1
#endif
#ifndef REP_P1
#define REP_P1 1
#endif
#ifndef REP_P5
#define REP_P5 1
#endif
#ifndef REP_P6
#define REP_P6 1
#endif
#ifndef REP_P3
#define REP_P3 1
#endif
#ifndef REP_P4
#define REP_P4 1
#endif
#ifndef SKIP_P0
#pragma unroll 1
    for (int rep = 0; rep < REP_P0; ++rep) {
        PHASE_PTRS();
        const int t0 = tid_now(wave); const int lane = t0 & 63;
        LAS float* scr = (LAS float*)(lds3 + wave * 16384);
        const int gw = bx * 8 + wave, NGW = G * 8;
        constexpr int IA = (DM / 64) * (INA / 32), IB = (DM / 64) * (INB / 32), IO = (BRW / 64) * (DM / 32), IM = (DM / 64) * (DM / 32);
        constexpr int NITEMS = IA + IB + 2 * IO + 2 * IM;
        for (int it = gw; it < NITEMS; it += NGW) {
            int r = it;
            if (r < IA) { transpose_item<1>(KARG(w_in_a), DM, INA, Wa_t, 0, KARG(norm_g), scr, r, lane); continue; } r -= IA;
            if (r < IB) { transpose_item<2>(KARG(w_in_b), DM, INB, Wb_t, 0, KARG(norm_g) + DM, scr, r, lane); continue; } r -= IB;
            if (r < IO) { transpose_item<0>(KARG(w_out), BRW, DM, Wo_t, 0, nullptr, scr, r, lane); continue; } r -= IO;
            if (r < IO) { transpose_item<0>(KARG(w_out) + (size_t)BRW * DM, BRW, DM, Wo_t + (size_t)DM * BRW, 0, nullptr, scr, r, lane); continue; } r -= IO;
            if (r < IM) { transpose_item<0>(KARG(w_mem_kv), DM, DM, Wm_t, 0, KARG(mem_norm_g), scr, r, lane); continue; } r -= IM;
            transpose_item<0>(KARG(w_mem_kv) + (size_t)DM * DM, DM, DM, Wm_t, DM, KARG(mem_norm_g) + DM, scr, r, lane);
        }
        {
            const float* xin = KARG(x); const float* min_ = KARG(mem);
            for (int m0 = gw; m0 < NTOK + BATCH * NMEM; m0 += 4 * NGW) {
                f32x4 v[4][4]; float ss_[4];
#pragma unroll
                for (int q = 0; q < 4; ++q) { const int m = m0 + q * NGW; ss_[q] = 0.f;
                    if (m < NTOK + BATCH * NMEM) { const f32x4* xr = (const f32x4*)(m < NTOK ? xin + (size_t)m * DM : min_ + (size_t)(m - NTOK) * DM) + lane;
#pragma unroll
                        for (int j = 0; j < 4; ++j) v[q][j] = xr[64 * j]; } }
#pragma unroll
                for (int q = 0; q < 4; ++q) { const int m = m0 + q * NGW;
                    if (m < NTOK + BATCH * NMEM) {
#pragma unroll
                        for (int j = 0; j < 4; ++j) ss_[q] += (v[q][j].x * v[q][j].x + v[q][j].y * v[q][j].y) + (v[q][j].z * v[q][j].z + v[q][j].w * v[q][j].w);
                        const float rstd = rsqrtf(wave_sum(ss_[q], lane) * (1.f / DM) + EPS);
                        bf16_t* orow = (m < NTOK) ? A0 + (size_t)(m / CTOK) * ((size_t)CTOK * BRW) + (size_t)(m % CTOK) * DM : memA + (size_t)(m - NTOK) * DM;
                        unsigned long long* o8 = (unsigned long long*)orow + lane;
#pragma unroll
                        for (int j = 0; j < 4; ++j) o8[64 * j] = (unsigned long long)pk2(v[q][j].x * rstd, v[q][j].y * rstd) | ((unsigned long long)pk2(v[q][j].z * rstd, v[q][j].w * rstd) << 32); } }
            }
        }
        for (int idx = bx * 512 + t0; idx < SEQ * 80; idx += G * 512) {
            const int t = idx / 80, i = idx % 80;
            if (i < 16) tabA[t * 16 + i] = cos_sin((double)t, 13.122363377404328  , (double)i / 16.0);
            else { const int k = i - 16, f = k & 31; tabB[t * 64 + k] = cos_sin((double)(k < 32 ? (t >> 6) : (t & 63)), 9.210340371976184  , (double)f / 32.0); }
        }
    }
#endif
    grid.sync();

#ifndef SKIP_PM
    {
        PHASE_PTRS();
        pg8::Gemm g2{launder(memA), launder(Wm_t), BATCH * NMEM, 2 * DM, DM}; pg8::StaticOrder S2; S2.init(BATCH * NMEM, 2 * DM, G, bx);
        EpiHead<1> E2{launder(MKV), nullptr, launder(KARG(mem_kn_g)), nullptr, nullptr, nullptr};
        pg8::gemm_phase(wave, lds3, g2, S2, E2);
    }
#endif
#pragma unroll 1
    for (int ch = 0; ch < NCH; ++ch) {
#ifndef SKIP_P1
#pragma unroll 1
        for (int rep = 0; rep < REP_P1; ++rep) {
            PHASE_PTRS();
            pg8::Gemm g{launder(A0 + (size_t)ch * CTOK * BRW), launder(Wa_t), CTOK, INA, DM}; pg8::StaticOrder S; S.init(CTOK, INA, G, bx, P1_WGM);
            EpiHead<0> E{launder(R), launder(KARG(qn_a)), launder(KARG(kn_a)), launder(KARG(mem_qn_g)), nullptr, launder(tabA)};
            pg8::gemm_phase(wave, lds3, g, S, E);
        }
#endif
        GRID_BAR();
#ifndef SKIP_P2
        {
            PHASE_PTRS();
            const bf16_t* QKV = launder(R + R_QKV / 2); const bf16_t* GATE = launder(R + R_GATE0 / 2); const bf16_t* QM = launder(R + R_QM0 / 2);
#ifdef PROBE_P2
#pragma unroll 1
            for (int rep2 = 0; rep2 < 2; ++rep2)
#endif
#pragma unroll 1
            for (int u = bx; u < 1536; u += G) {
                {
                    int bl, gg, h, qb;
                    if (u < 1024) { qb = u & 15; h = (u >> 4) & 7; gg = (u >> 7) & 1; bl = u >> 8; }
                    else { const int v = u - 1024; qb = v & 15; h = (v >> 4) & 7; bl = v >> 7; gg = 2; }
                    const int dl = 2 * gg, L = SEQ >> dl, i0g = qb * 256, res = i0g / L, i0 = i0g % L, NT = (L == 256) ? 4 : 6;
                    int ks = i0 - 64; if (ks < 0) ks = 0; if (ks > L - 64 * NT) ks = L - 64 * NT;
                    const size_t hb = (size_t)((bl * 3 + 0) * 3 + gg) * 8 + h;
                    const int dd = 1 << dl;
                    const bf16_t* Qp = QKV + (hb * 4096 + res + (size_t)i0 * dd) * 128;
                    const bf16_t* Kp = QKV + ((hb + 24) * 4096 + res + (size_t)ks * dd) * 128;
                    const bf16_t* Vp = QKV + ((hb + 48) * 4096 + res + (size_t)ks * dd) * 128;
                    att::EpiDil E{(bf16_t*)Qp, LSE + ((size_t)((bl * 3 + gg) * 8 + h)) * 4096 + res + i0 * dd, 128 * dd};
#ifdef PROBE_P2
                    if (rep2) { E.O = (bf16_t*)(dob + 96 * MiB); E.lse = (float*)(dob + 97 * MiB); }
#endif
                    att::attn_unit<true>(tid_now(wave), Qp, Kp, Vp, NT, ks - i0, (char*)lds, E, 128 * dd);
                }
            }
#pragma unroll 1
            for (int u = 1536 + bx; u < 1792; u += G) {
                {
                    const int v = u - 1536, qb = v & 15, mh = (v >> 4) & 3, bl = v >> 6, b = ch * CB + bl;
                    const bf16_t* Qp = QM + ((size_t)(bl * 4 + mh) * 4096 + qb * 256) * 128;
                    const bf16_t* Kp = MKV + (size_t)(((0 * 2 + 0) * 8 + b) * 4 + mh) * 256 * 128;
                    const bf16_t* Vp = MKV + (size_t)(((0 * 2 + 1) * 8 + b) * 4 + mh) * 256 * 128;
                    const size_t tl = (size_t)bl * 4096 + qb * 256;
                    att::EpiGate E{Y + ((size_t)ch * CTOK + tl) * BRW + 1024 + mh * 128, GATE + tl * BRW + 1024 + mh * 128};
                    att::attn_unit<false>(tid_now(wave), Qp, Kp, Vp, 4, 0, (char*)lds, E);
                }
            }
        }
#endif
        GRID_BAR();
#ifndef SKIP_P3
#pragma unroll 1
        for (int rep = 0; rep < REP_P3; ++rep) {
            PHASE_PTRS();
            const bf16_t* QKV = launder(R + R_QKV / 2); const bf16_t* GATE = launder(R + R_GATE0 / 2);
            const int t3 = tid_now(wave);
            for (int it = bx * 512 + t3; it < CTOK * 128; it += G * 512) {
                const int c = it & 15, h = (it >> 4) & 7, tl = it >> 7, bl = tl >> 12, t = tl & 4095;
                float ls[3]; bf16x8 ov[3];
#pragma unroll
                for (int gg = 0; gg < 3; ++gg) { const int p = t;
                    const size_t hb = (size_t)((bl * 3 + 0) * 3 + gg) * 8 + h;
                    ls[gg] = LSE[((size_t)((bl * 3 + gg) * 8 + h)) * 4096 + p];
                    ov[gg] = *(const bf16x8*)(QKV + (hb * 4096 + p) * 128 + c * 8); }
                const float mx = fmaxf(ls[0], fmaxf(ls[1], ls[2]));
                float w0 = __expf(ls[0] - mx), w1 = __expf(ls[1] - mx), w2 = __expf(ls[2] - mx); const float inv = 1.f / (w0 + w1 + w2); w0 *= inv; w1 *= inv; w2 *= inv;
                const bf16x8 gv = *(const bf16x8*)(GATE + (size_t)tl * BRW + h * 128 + c * 8);
                float r[8];
#pragma unroll
                for (int e = 0; e < 8; ++e) { const float o = w0 * bf2f((unsigned short)ov[0][e]) + w1 * bf2f((unsigned short)ov[1][e]) + w2 * bf2f((unsigned short)ov[2][e]);
                    r[e] = o * silu(bf2f((unsigned short)gv[e])); }
                u32x4 w; w.x = pk2(r[0], r[1]); w.y = pk2(r[2], r[3]); w.z = pk2(r[4], r[5]); w.w = pk2(r[6], r[7]);
                *(u32x4*)(Y + ((size_t)ch * CTOK + tl) * BRW + h * 128 + c * 8) = w;
            }
        }
#endif
        GRID_BAR();
    }

#ifndef SKIP_P4
#pragma unroll 1
    for (int rep = 0; rep < REP_P4; ++rep) {
        PHASE_PTRS();
        pg8::Gemm g{launder(Y), launder(Wo_t), NTOK, DM, BRW}; pg8::StaticOrder S; S.init(NTOK, DM, G, bx);
        EpiRes<true> E{launder(KARG(x)), launder(KARG(out)), launder(R + R_A1 / 2), launder(SS1)};
        pg8::gemm_phase(wave, lds3, g, S, E);
    }
#endif
    GRID_BAR();
#ifndef SKIP_P5
#pragma unroll 1
    for (int rep = 0; rep < REP_P5; ++rep) {
        PHASE_PTRS();
        pg8::Gemm g{launder(R + R_A1 / 2), launder(Wb_t), NTOK, INB, DM}; pg8::StaticOrder S; S.init(NTOK, INB, G, bx);
        EpiHead<2> E{launder(R), launder(KARG(qn_b)), launder(KARG(kn_b)), launder(KARG(mem_qn_g) + HD), launder(SS1), launder(tabB)};
        pg8::gemm_phase(wave, lds3, g, S, E);
    }
#endif
    GRID_BAR();
#ifndef SKIP_P6
#pragma unroll 1
    for (int rep = 0; rep < REP_P6; ++rep) {
        PHASE_PTRS();
        const bf16_t* Q1 = launder(R + R_Q1 / 2); const bf16_t* K1 = launder(R + R_K1 / 2); const bf16_t* V1 = launder(R + R_V1 / 2); const bf16_t* QM1 = launder(R + R_QM1 / 2); const bf16_t* GATE1 = launder(R + R_GATE1 / 2);
#pragma unroll 1
        for (int u = bx; u < 1024; u += G) {
            {
                int qb = u & 15, h = (u >> 4) & 7, b = u >> 7;
                if (G == 256) {
                    const int x = bx & 7, j = bx >> 3, r = u >> 8, pair = x + 8 * (r >> 1), idx = (r & 1) * 32 + j;
                    b = pair >> 1; h = (pair & 1) * 4 + (idx >> 4); qb = idx & 15; }
                const bf16_t* Qp = Q1 + ((size_t)(b * 8 + h) * 4096 + qb * 256) * 128;
                const bf16_t* Kp = K1 + (size_t)(b * 2 + (h >> 2)) * 4096 * 128;
                const bf16_t* Vp = V1 + (size_t)(b * 2 + (h >> 2)) * 4096 * 128;
                const size_t tl = (size_t)b * 4096 + qb * 256;
                att::EpiGate E{Y + tl * BRW + h * 128, GATE1 + tl * BRW + h * 128};
                att::attn_unit<false>(tid_now(wave), Qp, Kp, Vp, 64, 0, (char*)lds, E);
            }
        }
#pragma unroll 1
        for (int u = 1024 + bx; u < 1536; u += G) {
            {
                const int v = u - 1024, qb = v & 15, mh = (v >> 4) & 3, b = v >> 6;
                const bf16_t* Qp = QM1 + ((size_t)(b * 4 + mh) * 4096 + qb * 256) * 128;
                const bf16_t* Kp = MKV + (size_t)(((1 * 2 + 0) * 8 + b) * 4 + mh) * 256 * 128;
                const bf16_t* Vp = MKV + (size_t)(((1 * 2 + 1) * 8 + b) * 4 + mh) * 256 * 128;
                const size_t tl = (size_t)b * 4096 + qb * 256;
                att::EpiGate E{Y + tl * BRW + 1024 + mh * 128, GATE1 + tl * BRW + 1024 + mh * 128};
                att::attn_unit<false>(tid_now(wave), Qp, Kp, Vp, 4, 0, (char*)lds, E);
            }
        }
    }
#endif
    GRID_BAR();
#ifndef SKIP_P7
    {
        PHASE_PTRS();
        pg8::Gemm g{launder(Y), launder(Wo_t + (size_t)DM * BRW), NTOK, DM, BRW}; pg8::StaticOrder S; S.init(NTOK, DM, G, bx);
        EpiRes<false> E{launder(KARG(out)), launder(KARG(out)), nullptr, nullptr};
        pg8::gemm_phase(wave, lds3, g, S, E);
    }
#endif
#ifdef PROBE_SYNC
#pragma unroll 1
    for (int i = 0; i < PROBE_SYNC; ++i) GRID_BAR();
#endif
#ifdef PROBE_GEMM
    GRID_BAR();
    {
        PHASE_PTRS();
        pg8::Gemm g{launder(Y), launder(Wb_t), NTOK, INB, DM}; pg8::StaticOrder S; S.init(NTOK, INB, G, bx);
        EpiPlain E{launder(R), INB};
        pg8::gemm_phase(wave, lds3, g, S, E);
    }
#endif
}

extern "C" void kernel_launch(void* const* d_in, const int* in_sizes, int n_in, void* d_out, int out_size, void* d_ws, size_t ws_size, hipStream_t stream) {
    static int grid = 0;
    if (grid == 0) {
        if (n_in != 14 || out_size != NTOK * DM || ws_size < WS_END2) { fprintf(stderr, "kernel_launch: unexpected shapes (n_in %d out %d ws %zu)\n", n_in, out_size, ws_size); grid = -1; return; }
        int dev = 0, cus = 0, per_cu = 0;
        if (hipGetDevice(&dev) != hipSuccess || hipDeviceGetAttribute(&cus, hipDeviceAttributeMultiprocessorCount, dev) != hipSuccess) { grid = -1; return; }
        if (hipFuncSetAttribute((const void*)mega_fwd, hipFuncAttributeMaxDynamicSharedMemorySize, LDS_BYTES) != hipSuccess) { fprintf(stderr, "kernel_launch: hipFuncSetAttribute failed\n"); grid = -1; return; }
        if (hipOccupancyMaxActiveBlocksPerMultiprocessor(&per_cu, (const void*)mega_fwd, 512, LDS_BYTES) != hipSuccess || per_cu < 1) { fprintf(stderr, "kernel_launch: occupancy query says %d\n", per_cu); grid = -1; return; }
        grid = cus;
    }
    if (grid < 0) return;
    if (hipMemsetAsync((char*)d_ws + WS_BAR, 0, XCD_BAR_WORDS * 4, stream) != hipSuccess) { fprintf(stderr, "kernel_launch: memset failed\n"); return; }
    Params p{};
    p.x = (const float*)d_in[0]; p.mem = (const float*)d_in[1]; p.norm_g = (const float*)d_in[2]; p.mem_norm_g = (const float*)d_in[3];
    p.w_mem_kv = (const float*)d_in[4]; p.mem_qn_g = (const float*)d_in[5]; p.mem_kn_g = (const float*)d_in[6]; p.w_out = (const float*)d_in[7];
    p.w_in_a = (const float*)d_in[8]; p.qn_a = (const float*)d_in[9]; p.kn_a = (const float*)d_in[10]; p.w_in_b = (const float*)d_in[11];
    p.qn_b = (const float*)d_in[12]; p.kn_b = (const float*)d_in[13]; p.out = (float*)d_out; p.ws = (unsigned char*)d_ws;
    void* args[] = {&p};
    hipError_t e = hipLaunchCooperativeKernel((const void*)mega_fwd, dim3(grid), dim3(512), args, LDS_BYTES, stream);
    if (e != hipSuccess) fprintf(stderr, "cooperative launch failed: %s (grid %d)\n", hipGetErrorString(e), grid);
}
```

```cpp
#include <hip/hip_runtime.h>
#include <hip/hip_cooperative_groups.h>
#include <cstdio>
#include <cstdint>
#include <cmath>
#include <cstddef>
namespace cg = cooperative_groups;

#define LAS __attribute__((address_space(3)))
typedef unsigned short bf16_t;
typedef short bf16x8 __attribute__((ext_vector_type(8)));
typedef short s16x4 __attribute__((ext_vector_type(4)));
typedef float f32x4 __attribute__((ext_vector_type(4)));
typedef float f32x2 __attribute__((ext_vector_type(2)));
typedef float f32x16 __attribute__((ext_vector_type(16)));
typedef unsigned u32x4 __attribute__((ext_vector_type(4)));

constexpr int BATCH = 8, SEQ = 4096, DM = 1024, NTOK = BATCH * SEQ;
constexpr int HD = 128, NMEM = 256;
constexpr int INA = 11264, INB = 3584, BRW = 1536;
constexpr int NCH = 2, CB = BATCH / NCH, CTOK = CB * SEQ;
constexpr float EPS = 1e-6f;
constexpr float SCALE = 0.088388347648318440f;

constexpr size_t MiB = 1u << 20;
constexpr size_t WS_WB = 0, WS_WO = 8 * MiB, WS_WM = 14 * MiB, WS_MKV = 18 * MiB, WS_TABA = 26 * MiB, WS_TABB = 27 * MiB, WS_SS1 = 29 * MiB, WS_LSE = 31 * MiB;
constexpr size_t WS_BAR = 33 * MiB;
constexpr size_t WS_Y = 34 * MiB, WS_R = 130 * MiB, WS_END = 482 * MiB;
constexpr size_t R_QKV = 0, R_GATE0 = 288 * MiB, R_QM0 = 336 * MiB;
constexpr size_t R_A1 = 0, R_Q1 = 64 * MiB, R_K1 = 128 * MiB, R_V1 = 144 * MiB, R_QM1 = 160 * MiB, R_GATE1 = 192 * MiB;
constexpr size_t WS_WA = 482 * MiB, WS_MEMA = 505 * MiB, WS_END2 = 509 * MiB;

__device__ __forceinline__ unsigned f2bf(float f) { unsigned u = __builtin_bit_cast(unsigned, f); return (u + 0x7fffu + ((u >> 16) & 1u)) >> 16; }
__device__ __forceinline__ unsigned pk2(float lo, float hi) { return f2bf(lo) | (f2bf(hi) << 16); }
__device__ __forceinline__ float bf2f(unsigned short b) { return __uint_as_float(((unsigned)b) << 16); }
__device__ __forceinline__ unsigned cvt_pk_bf16(float lo, float hi) { unsigned r; asm volatile("v_cvt_pk_bf16_f32 %0, %1, %2" : "=v"(r) : "v"(lo), "v"(hi)); return r; }
__device__ __forceinline__ int tid_now(int wave_s) { int l; asm volatile("v_mbcnt_lo_u32_b32 %0, -1, 0\n\tv_mbcnt_hi_u32_b32 %0, -1, %0" : "=v"(l)); l = (wave_s << 6) | l; __builtin_assume(l >= 0 && l < 512); return l; }
template <class T> __device__ __forceinline__ T* as_global(T* p) { return (T*)(__attribute__((address_space(1))) T*)p; }
__device__ __forceinline__ float shfl_xor_l(float v, int m, int lane) { return __int_as_float(__builtin_amdgcn_ds_bpermute((lane ^ m) << 2, __float_as_int(v))); }
__device__ __forceinline__ float silu(float g) { return g / (1.f + __expf(-g)); }

namespace pg8 {
constexpr int BM = 256, BK = 64, HALF = 128, HTB = HALF * BK * 2, STAGE_BYTES = 8 * HTB, NXCD = 8, WGM = 8;
__host__ __device__ __forceinline__ int lds_byte(int r, int c) { const int st = (r >> 4) * 2 + (c >> 5), rr = r & 15, cc = c & 31, ob = rr * 64 + cc * 2; return st * 1024 + (ob ^ (((ob >> 9) & 1) << 5)); }
__host__ __device__ __forceinline__ void stage_rc(int b, int& R, int& C) { const int st = b / 1024, sb = b % 1024, swz = sb ^ (((sb >> 9) & 1) << 5); R = (st >> 1) * 16 + swz / 64; C = (st & 1) * 32 + (swz % 64) / 2; }
__host__ __device__ __forceinline__ int perm32(int rho) { const int n = rho >> 4, i = rho & 15; return 8 * (i >> 2) + 4 * n + (i & 3); }
struct Unit { int pm, pn; };
struct Gemm { const bf16_t* A; const bf16_t* Bt; int M, N, K; };
struct StaticOrder {
    int nM, nN, nwg, G, c, wgm;
    __host__ __device__ void init(int M, int N, int G_, int c_, int wgm_ = WGM) { nM = M / BM; nN = N / BM; nwg = nM * nN; G = G_; c = c_; wgm = wgm_; }
    __host__ __device__ bool next(int i, Unit& u) const {
        const long L = (long)i * G + c; if (L >= nwg) return false;
        int wgid = (int)L; { const int q = nwg / NXCD, r = nwg % NXCD, xcd = wgid % NXCD, off = wgid / NXCD; wgid = (xcd < r ? xcd * (q + 1) : r * (q + 1) + (xcd - r) * q) + off; }
        const int nig = wgm * nN, gid = wgid / nig, fm = gid * wgm, gsz = (nM - fm) < wgm ? (nM - fm) : wgm;
        u.pm = fm + ((wgid % nig) % gsz); u.pn = (wgid % nig) / gsz; return true;
    }
};

template <class Epi>
__device__ __forceinline__ void gemm_phase(const int wave_s, LAS unsigned char* lds, const Gemm g, const StaticOrder& S, const Epi& E) {
    const int tid = tid_now(wave_s);
    int wid = wave_s; asm volatile("" : "+s"(wid));
    const int lane = tid & 63, wr = wid >> 2, wc = wid & 3, fr = lane & 15, fq = lane >> 4;
    const int K = g.K, nt = K / BK;
    unsigned voffA[2], voffB[2];
#pragma unroll
    for (int i = 0; i < 2; ++i) { int R, C; stage_rc(tid * 16 + i * 8192, R, C); const int Rb = (R & ~31) + perm32(R & 31);
        voffA[i] = (unsigned)(R * K + C) * 2u; voffB[i] = (unsigned)(Rb * K + C) * 2u; }
    const size_t kstep = (size_t)(BK * 2);
    const size_t hstep = (size_t)HALF * K * 2;
    const size_t tstep = 2 * hstep;
    const unsigned ldsw = (unsigned)wid * 1024u;
    const int aoff = lds_byte(wr * 64 + fr, fq * 8), boff = lds_byte(wc * 32 + fr, fq * 8);
#define PG8_SA(b, h) (((b) * 2 + (h)) * HTB)
#define PG8_SB(b, h) ((4 + (b) * 2 + (h)) * HTB)
#define PG8_STAGE(bufoff, gbase, voff) do { _Pragma("unroll") for (int _i = 0; _i < 2; ++_i) \
        __builtin_amdgcn_global_load_lds((const unsigned*)((const char*)(gbase) + (voff)[_i]), (LAS unsigned*)(lds + (bufoff) + ldsw + _i * 8192), 16, 0, 0); } while (0)
#define PG8_LDA(dst, b, h) do { _Pragma("unroll") for (int m = 0; m < 4; ++m) _Pragma("unroll") for (int k = 0; k < 2; ++k) dst[m][k] = *(const LAS bf16x8*)(lds + PG8_SA(b, h) + aoff + m * 2048 + k * 1024); } while (0)
#define PG8_LDB(dst, b, h) do { _Pragma("unroll") for (int n = 0; n < 2; ++n) _Pragma("unroll") for (int k = 0; k < 2; ++k) dst[n][k] = *(const LAS bf16x8*)(lds + PG8_SB(b, h) + boff + n * 2048 + k * 1024); } while (0)
#define PG8_MMA(ai, bj, At, Bt) do { __builtin_amdgcn_s_setprio(1); _Pragma("unroll") for (int m = 0; m < 4; ++m) _Pragma("unroll") for (int n = 0; n < 2; ++n) _Pragma("unroll") for (int k = 0; k < 2; ++k) \
        acc[ai][bj][m][n] = __builtin_amdgcn_mfma_f32_16x16x32_bf16(Bt[n][k], At[m][k], acc[ai][bj][m][n], 0, 0, 0); __builtin_amdgcn_s_setprio(0); } while (0)
#define PG8_WAIT_V(n) asm volatile("s_waitcnt vmcnt(" #n ")" ::: "memory")
#define PG8_WAIT_L(n) asm volatile("s_waitcnt lgkmcnt(" #n ")" ::: "memory")
#define PG8_BAR __builtin_amdgcn_s_barrier()
#define PG8_SCHED __builtin_amdgcn_sched_barrier(0)
    Unit cur, nxt; int ui = 0;
    if (!S.next(0, cur)) return;
    f32x4 acc[2][2][4][2];
#pragma unroll
    for (int a = 0; a < 2; ++a)
#pragma unroll
        for (int b = 0; b < 2; ++b)
#pragma unroll
            for (int m = 0; m < 4; ++m)
#pragma unroll
                for (int n = 0; n < 2; ++n) acc[a][b][m][n] = (f32x4){0.f, 0.f, 0.f, 0.f};
    bf16x8 At[4][2], B0[2][2], B1[2][2];
    const char* cA = (const char*)g.A + (size_t)cur.pm * tstep; const char* cB = (const char*)g.Bt + (size_t)cur.pn * tstep;
    PG8_STAGE(PG8_SB(0, 0), cB, voffB); PG8_STAGE(PG8_SB(0, 1), cB + hstep, voffB); PG8_STAGE(PG8_SA(0, 0), cA, voffA); PG8_STAGE(PG8_SA(0, 1), cA + hstep, voffA);
    if (wr == 1) PG8_BAR;
    PG8_WAIT_V(2); PG8_BAR;
    PG8_STAGE(PG8_SB(1, 0), cB + kstep, voffB); PG8_STAGE(PG8_SA(1, 0), cA + kstep, voffA); PG8_STAGE(PG8_SB(1, 1), cB + hstep + kstep, voffB);
    PG8_WAIT_V(6); PG8_BAR;
    for (;;) {
        const bool has_next = S.next(ui + 1, nxt);
        const char* nA = has_next ? (const char*)g.A + (size_t)nxt.pm * tstep : cA; const char* nB = has_next ? (const char*)g.Bt + (size_t)nxt.pn * tstep : cB;
        for (int t = 0; t < nt; t += 2) {
            const bool last = (t == nt - 2);
            const char* a1 = cA + (size_t)(t + 1) * kstep;
            const char* a2 = last ? nA : cA + (size_t)(t + 2) * kstep; const char* b2 = last ? nB : cB + (size_t)(t + 2) * kstep;
            const char* a3 = a2 + kstep; const char* b3 = b2 + kstep;
            PG8_LDB(B0, 0, 0); PG8_LDB(B1, 0, 1); PG8_SCHED; PG8_LDA(At, 0, 0); PG8_STAGE(PG8_SA(1, 1), a1 + hstep, voffA);
            PG8_WAIT_V(8); PG8_WAIT_L(0); PG8_BAR; PG8_MMA(0, 0, At, B0); PG8_MMA(0, 1, At, B1); PG8_BAR; PG8_SCHED;
            PG8_LDA(At, 0, 1); PG8_STAGE(PG8_SB(0, 0), b2, voffB); PG8_STAGE(PG8_SB(0, 1), b2 + hstep, voffB); PG8_STAGE(PG8_SA(0, 0), a2, voffA);
            PG8_WAIT_V(8); PG8_WAIT_L(0); PG8_BAR; PG8_MMA(1, 0, At, B0); PG8_MMA(1, 1, At, B1); PG8_BAR; PG8_SCHED;
            PG8_LDB(B0, 1, 0); PG8_LDB(B1, 1, 1); PG8_SCHED; PG8_LDA(At, 1, 0); PG8_STAGE(PG8_SA(0, 1), a2 + hstep, voffA);
            PG8_WAIT_V(8); PG8_WAIT_L(0); PG8_BAR; PG8_MMA(0, 0, At, B0); PG8_MMA(0, 1, At, B1); PG8_BAR; PG8_SCHED;
            PG8_LDA(At, 1, 1); PG8_STAGE(PG8_SB(1, 0), b3, voffB); PG8_STAGE(PG8_SB(1, 1), b3 + hstep, voffB); PG8_STAGE(PG8_SA(1, 0), a3, voffA);
            PG8_WAIT_V(8); PG8_WAIT_L(0); PG8_BAR; PG8_MMA(1, 0, At, B0); PG8_MMA(1, 1, At, B1); PG8_BAR; PG8_SCHED;
        }
        if (wr == 0) PG8_BAR;
        E(acc, cur, wr, wc, fr, fq, (LAS float*)(lds + STAGE_BYTES));
        if (!has_next) break;
#pragma unroll
        for (int a = 0; a < 2; ++a)
#pragma unroll
            for (int b = 0; b < 2; ++b)
#pragma unroll
                for (int m = 0; m < 4; ++m)
#pragma unroll
                    for (int n = 0; n < 2; ++n) acc[a][b][m][n] = (f32x4){0.f, 0.f, 0.f, 0.f};
        cur = nxt; cA = nA; cB = nB; ++ui;
        if (wr == 1) PG8_BAR;
    }
    PG8_WAIT_V(0);
    PG8_BAR;
#undef PG8_SA
#undef PG8_SB
#undef PG8_STAGE
#undef PG8_LDA
#undef PG8_LDB
#undef PG8_MMA
#undef PG8_WAIT_V
#undef PG8_WAIT_L
#undef PG8_BAR
#undef PG8_SCHED
}
}

template <int KIND> struct EpiHead {
    bf16_t* R;
    const float* gq; const float* gk; const float* gm;
    const float* ss;
    const f32x2* tab;
    __device__ __forceinline__ void operator()(f32x4 (&acc)[2][2][4][2], const pg8::Unit& u, int wr, int wc, int fr, int fq, LAS float* xl) const {
        int ln_;
        { const int t_ = tid_now(wr * 4 + wc); fr = t_ & 15; fq = (t_ >> 4) & 3; ln_ = t_ & 63; }
        const int rloc = wr * 64 + fr;
        const int rbase = u.pm * 256 + rloc;
        const int pb = wc * 4 + fq;
        bool norm[2], rowmajor[2], qsc[2]; const float* g[2]; bf16_t* base[2]; int bs[2], gcol[2]; int rope = 0, dl = 0, sh = 12;
#pragma unroll
        for (int bj = 0; bj < 2; ++bj) {
            const int hd = u.pn * 2 + bj; norm[bj] = false; rowmajor[bj] = false; g[bj] = nullptr; base[bj] = R; bs[bj] = 0; gcol[bj] = 0;
            qsc[bj] = (KIND == 0) ? (hd < 24 || (hd >= 72 && hd < 76)) : (KIND == 2) ? (hd < 8 || (hd >= 12 && hd < 16)) : false;
            if (KIND == 0) {
                if (hd < 72) { const int tsel = hd / 24, gg = (hd >> 3) % 3, h = hd & 7; norm[bj] = tsel < 2; if (tsel < 2) rope = 1; g[bj] = (tsel == 0 ? gq : gk) + gg * 128;
                    dl = 2 * gg; bs[bj] = 3 * 3 * 8 * 4096; base[bj] = R + (R_QKV / 2) + (size_t)((tsel * 3 + gg) * 8 + h) * 4096 * 128; }
                else if (hd < 76) { norm[bj] = true; g[bj] = gm; bs[bj] = 4 * 4096; base[bj] = R + (R_QM0 / 2) + (size_t)(hd - 72) * 4096 * 128; }
                else { rowmajor[bj] = true; gcol[bj] = (hd - 76) * 128; base[bj] = R + (R_GATE0 / 2); }
            } else if (KIND == 2) {
                if (hd < 8) { norm[bj] = true; rope = 2; g[bj] = gq; bs[bj] = 8 * 4096; base[bj] = R + (R_Q1 / 2) + (size_t)hd * 4096 * 128; }
                else if (hd < 10) { norm[bj] = true; rope = 2; g[bj] = gk; bs[bj] = 2 * 4096; base[bj] = R + (R_K1 / 2) + (size_t)(hd - 8) * 4096 * 128; }
                else if (hd < 12) { bs[bj] = 2 * 4096; base[bj] = R + (R_V1 / 2) + (size_t)(hd - 10) * 4096 * 128; }
                else if (hd < 16) { norm[bj] = true; g[bj] = gm; bs[bj] = 4 * 4096; base[bj] = R + (R_QM1 / 2) + (size_t)(hd - 12) * 4096 * 128; }
                else { rowmajor[bj] = true; gcol[bj] = (hd - 16) * 128; base[bj] = R + (R_GATE1 / 2); }
            } else {
                const int layer = hd >> 3, tt = (hd >> 2) & 1, mh = hd & 3; norm[bj] = tt == 0; g[bj] = gk + layer * 128; sh = 8; bs[bj] = 4 * 256;
                base[bj] = R + (size_t)(((layer * 2 + tt) * 8) * 4 + mh) * 256 * 128;
            }
        }
        const bool anynorm = norm[0] || norm[1];
        if (anynorm) {
#pragma unroll
        for (int ai = 0; ai < 2; ++ai)
#pragma unroll
            for (int m = 0; m < 4; ++m)
#pragma unroll
                for (int bj = 0; bj < 2; ++bj) {
                    const f32x4 a = acc[ai][bj][m][0], b = acc[ai][bj][m][1];
                    float s = (a.x * a.x + a.y * a.y) + (a.z * a.z + a.w * a.w) + (b.x * b.x + b.y * b.y) + (b.z * b.z + b.w * b.w);
                    s += shfl_xor_l(s, 16, ln_); s += shfl_xor_l(s, 32, ln_);
                    if (fq == 0) xl[((ai * 128 + m * 16 + rloc) * 2 + bj) * 4 + wc] = s;
                }
        }
        const int np = (rope == 2) ? 64 : 16;
        const bool dorope = (rope == 2) || (rope == 1 && pb < 4);
        f32x4 tc0 = (f32x4){1.f, 0.f, 1.f, 0.f}, tc1 = tc0;
        if (dorope) { const f32x4* tp = as_global((const f32x4*)(tab + (size_t)(rbase & 4095) * np + 4 * pb)); tc0 = tp[0]; tc1 = tp[1]; }
        float fac[2][4][2];
#pragma unroll
        for (int ai = 0; ai < 2; ++ai)
#pragma unroll
            for (int m = 0; m < 4; ++m) {
                float r_ = 1.f;
                if (KIND == 2) { const f32x4 a = *(const f32x4*)(ss + (size_t)(rbase + ai * 128 + m * 16) * 4); r_ = rsqrtf(((a.x + a.y) + (a.z + a.w)) * (1.0f / 1024.0f) + EPS); }
                fac[ai][m][0] = r_; fac[ai][m][1] = r_;
            }
        if (anynorm) { asm volatile("s_waitcnt lgkmcnt(0)" ::: "memory"); __builtin_amdgcn_s_barrier(); asm volatile("" ::: "memory"); }
#pragma unroll
        for (int ai = 0; ai < 2; ++ai)
#pragma unroll
            for (int m = 0; m < 4; ++m)
#pragma unroll
                for (int bj = 0; bj < 2; ++bj)
                    if (norm[bj]) {
                        const f32x4 pp = *(const LAS f32x4*)(xl + ((ai * 128 + m * 16 + rloc) * 2 + bj) * 4);
                        const float r_ = fac[ai][m][bj];
                        fac[ai][m][bj] = r_ * rsqrtf(((pp.x + pp.y) + (pp.z + pp.w)) * (r_ * r_) * (1.0f / 128.0f) + EPS);
                    }
        int dlo = pb * 8, dhi = pb * 8 + 4;
        if (rope == 1 && pb < 4) { dlo = 4 * pb; dhi = 16 + 4 * pb; }
        if (rope == 2) { dlo = 4 * pb; dhi = 64 + 4 * pb; }
        f32x4 g0[2], g1[2];
#pragma unroll
        for (int bj = 0; bj < 2; ++bj) { g0[bj] = (f32x4){1.f, 1.f, 1.f, 1.f}; g1[bj] = g0[bj]; if (norm[bj]) { g0[bj] = *(const f32x4*)(g[bj] + dlo); g1[bj] = *(const f32x4*)(g[bj] + dhi); } }
#pragma unroll
        for (int ai = 0; ai < 2; ++ai)
#pragma unroll
            for (int m = 0; m < 4; ++m) {
                const int row = rbase + ai * 128 + m * 16, t = row & ((1 << sh) - 1);
                const f32x4 c01 = tc0, c23 = tc1;
                if (dorope && (ai * 4 + m) < 7) {
                    const int nrow = rbase + ((ai * 4 + m + 1) >> 2) * 128 + ((ai * 4 + m + 1) & 3) * 16;
                    const f32x4* tp = as_global((const f32x4*)(tab + (size_t)(nrow & 4095) * np + 4 * pb)); tc0 = tp[0]; tc1 = tp[1]; }
                const f32x4 cs = (f32x4){c01.x, c01.z, c23.x, c23.z}, sn = (f32x4){c01.y, c01.w, c23.y, c23.w};
                const int p = t;
#pragma unroll
                for (int bj = 0; bj < 2; ++bj) {
                    const float f = qsc[bj] ? fac[ai][m][bj] * (SCALE * 1.4426950408889634f) : fac[ai][m][bj];
                    f32x4 v0 = acc[ai][bj][m][0] * f * g0[bj], v1 = acc[ai][bj][m][1] * f * g1[bj];
                    if (dorope) { const f32x4 o0 = v0 * cs - v1 * sn, o1 = v1 * cs + v0 * sn; v0 = o0; v1 = o1; }
                    u32x4 w; w.x = cvt_pk_bf16(v0[0], v0[1]); w.y = cvt_pk_bf16(v0[2], v0[3]); w.z = cvt_pk_bf16(v1[0], v1[1]); w.w = cvt_pk_bf16(v1[2], v1[3]);
                    bf16_t* dst;
                    if (rowmajor[bj]) dst = base[bj] + (size_t)row * BRW + gcol[bj] + pb * 8;
                    else dst = base[bj] + ((size_t)(row >> sh) * bs[bj] + p) * 128 + pb * 8;
                    *(u32x4*)dst = w;
                }
                asm volatile("" ::: "memory");
            }
    }
};

struct EpiPlain {
    bf16_t* O; int ldc;
    __device__ __forceinline__ void operator()(f32x4 (&acc)[2][2][4][2], const pg8::Unit& u, int wr, int wc, int fr, int fq, LAS float* xl) const {
        { const int t_ = tid_now(wr * 4 + wc); fr = t_ & 15; fq = (t_ >> 4) & 3; }
        const int rbase = u.pm * 256 + wr * 64 + fr, cbase = u.pn * 256 + wc * 32 + 8 * fq;
#pragma unroll
        for (int ai = 0; ai < 2; ++ai)
#pragma unroll
            for (int m = 0; m < 4; ++m)
#pragma unroll
                for (int bj = 0; bj < 2; ++bj) { const f32x4 v0 = acc[ai][bj][m][0], v1 = acc[ai][bj][m][1];
                    u32x4 w; w.x = cvt_pk_bf16(v0[0], v0[1]); w.y = cvt_pk_bf16(v0[2], v0[3]); w.z = cvt_pk_bf16(v1[0], v1[1]); w.w = cvt_pk_bf16(v1[2], v1[3]);
                    *(u32x4*)(O + (size_t)(rbase + ai * 128 + m * 16) * ldc + cbase + bj * 128) = w; }
    }
};
template <bool FIRST> struct EpiRes {
    const float* xi; float* xo; bf16_t* A1; float* ss;
    __device__ __forceinline__ void operator()(f32x4 (&acc)[2][2][4][2], const pg8::Unit& u, int wr, int wc, int fr, int fq, LAS float* xl) const {
        int ln_;
        { const int t_ = tid_now(wr * 4 + wc); fr = t_ & 15; fq = (t_ >> 4) & 3; ln_ = t_ & 63; }
        const int rbase = u.pm * 256 + wr * 64 + fr, cbase = u.pn * 256 + wc * 32 + 8 * fq;
#pragma unroll
        for (int ai = 0; ai < 2; ++ai)
#pragma unroll
            for (int m = 0; m < 4; ++m) {
                const int row = rbase + ai * 128 + m * 16; float s = 0.f;
#pragma unroll
                for (int bj = 0; bj < 2; ++bj) {
                    const size_t off = (size_t)row * DM + cbase + bj * 128;
                    const f32x4 xa = *(const f32x4*)(xi + off), xb = *(const f32x4*)(xi + off + 4);
                    const f32x4 v0 = acc[ai][bj][m][0] + xa, v1 = acc[ai][bj][m][1] + xb;
                    *(f32x4*)(xo + off) = v0; *(f32x4*)(xo + off + 4) = v1;
                    if (FIRST) {
                        u32x4 w; w.x = cvt_pk_bf16(v0[0], v0[1]); w.y = cvt_pk_bf16(v0[2], v0[3]); w.z = cvt_pk_bf16(v1[0], v1[1]); w.w = cvt_pk_bf16(v1[2], v1[3]);
                        *(u32x4*)(A1 + off) = w;
                        s += (v0.x * v0.x + v0.y * v0.y) + (v0.z * v0.z + v0.w * v0.w) + (v1.x * v1.x + v1.y * v1.y) + (v1.z * v1.z + v1.w * v1.w);
                    }
                }
                if (FIRST) { s += shfl_xor_l(s, 16, ln_); s += shfl_xor_l(s, 32, ln_); if (fq == 0) xl[(ai * 128 + m * 16 + wr * 64 + fr) * 4 + wc] = s; }
                asm volatile("" ::: "memory");
            }
        if (FIRST) {
            asm volatile("s_waitcnt lgkmcnt(0)" ::: "memory"); __builtin_amdgcn_s_barrier(); asm volatile("" ::: "memory");
            if (wc == 0 && fq == 0) {
#pragma unroll
                for (int ai = 0; ai < 2; ++ai)
#pragma unroll
                    for (int m = 0; m < 4; ++m) { const f32x4 pp = *(const LAS f32x4*)(xl + (ai * 128 + m * 16 + wr * 64 + fr) * 4);
                        ss[(size_t)(rbase + ai * 128 + m * 16) * 4 + u.pn] = (pp.x + pp.y) + (pp.z + pp.w); }
            }
        }
    }
};

namespace att {
constexpr int D = 128, NW = 8, QBLK = 32, KVBLK = 64;
constexpr float THR = 8.f;
#ifndef ATT_SDEPTH
#define ATT_SDEPTH 2
#endif
constexpr int SDEPTH = ATT_SDEPTH;
constexpr size_t SHM_V = KVBLK * D * 2, SHM_K = KVBLK * D * 2, SHM_ATTN = 2 * SHM_V + 2 * SHM_K + NW * 64 * 4;
#define KSWZ(row, colB) ((row) * 256 + ((colB) ^ (((row) & 7) << 4)))
#define SBAR() __builtin_amdgcn_sched_barrier(0)
__device__ __forceinline__ int crow(int r, int hi) { return (r & 3) + 8 * (r >> 2) + 4 * hi; }
__device__ __forceinline__ unsigned cvtpk(float lo, float hi) { unsigned r; asm volatile("v_cvt_pk_bf16_f32 %0, %1, %2" : "=v"(r) : "v"(lo), "v"(hi)); return r; }
__device__ __forceinline__ void band_mask(f32x16& p0, f32x16& p1, int base) {
#pragma unroll
    for (int r = 0; r < 16; ++r) { const int c = (r & 3) + 8 * (r >> 2);
        if ((unsigned)(base + c + 64) > 128u) p0[r] = -INFINITY;
        if ((unsigned)(base + c + 32 + 64) > 128u) p1[r] = -INFINITY; }
}
template <bool FIRST = false>
__device__ __forceinline__ void partialSM(f32x16& p0, f32x16& p1, float& mhat, f32x16& negm, float& alpha) {
    constexpr float THR2 = THR * 1.4426950408889634f;
    float pmax = p0[0];
#pragma unroll
    for (int r = 1; r < 16; ++r) pmax = fmaxf(pmax, p0[r]);
#pragma unroll
    for (int r = 0; r < 16; ++r) pmax = fmaxf(pmax, p1[r]);
    { auto rr = __builtin_amdgcn_permlane32_swap(__float_as_uint(pmax), __float_as_uint(pmax), false, false);
      pmax = fmaxf(__uint_as_float(rr[0]), __uint_as_float(rr[1])); }
    if (!FIRST && __builtin_expect(__all(pmax <= THR2), 1)) { alpha = 1.f; }
    else { const float dl = FIRST ? (pmax > -1e30f ? pmax : 0.f) : fmaxf(pmax, 0.f); mhat += dl; alpha = FIRST ? 1.f : __builtin_amdgcn_exp2f(-dl);
#pragma unroll
        for (int r = 0; r < 16; ++r) { p0[r] -= dl; p1[r] -= dl; }
#pragma unroll
        for (int r = 0; r < 16; ++r) negm[r] = -mhat; }
#pragma unroll
    for (int r = 0; r < 16; ++r) p0[r] = __builtin_amdgcn_exp2f(p0[r]);
}
__device__ __forceinline__ void finishSM(f32x16& p0, f32x16& p1, float alpha, float& l_reg, bf16x8& pa0, bf16x8& pa1, bf16x8& pa2, bf16x8& pa3) {
#pragma unroll
    for (int r = 0; r < 16; ++r) p1[r] = __builtin_amdgcn_exp2f(p1[r]);
    float ps = 0;
#pragma unroll
    for (int r = 0; r < 16; ++r) ps += p0[r];
#pragma unroll
    for (int r = 0; r < 16; ++r) ps += p1[r];
    { auto rr = __builtin_amdgcn_permlane32_swap(__float_as_uint(ps), __float_as_uint(ps), false, false);
      ps = __uint_as_float(rr[0]) + __uint_as_float(rr[1]); }
    l_reg = l_reg * alpha + ps;
#define PK4(P, BASE, OUT) do { unsigned a0 = cvtpk(P[BASE + 0], P[BASE + 1]), a1 = cvtpk(P[BASE + 2], P[BASE + 3]);   \
    unsigned b0 = cvtpk(P[BASE + 4], P[BASE + 5]), b1 = cvtpk(P[BASE + 6], P[BASE + 7]);                              \
    auto r0 = __builtin_amdgcn_permlane32_swap(a0, b0, false, false); auto r1 = __builtin_amdgcn_permlane32_swap(a1, b1, false, false); \
    u32x4 w = {r0[0], r1[0], r0[1], r1[1]}; OUT = *reinterpret_cast<bf16x8*>(&w); } while (0)
    PK4(p0, 0, pa0); PK4(p0, 8, pa1); PK4(p1, 0, pa2); PK4(p1, 8, pa3);
#undef PK4
}
__device__ __forceinline__ void qkt(f32x16& p0, f32x16& p1, const bf16_t* Ks, const bf16x8* qr, const f32x16& negm, int r32, int hi) {
#pragma unroll
    for (int d0 = 0; d0 < 8; ++d0) { int cb = (d0 * 16 + hi * 8) * 2;
        bf16x8 b0 = *reinterpret_cast<const bf16x8*>((const char*)Ks + KSWZ(r32, cb));
        bf16x8 b1 = *reinterpret_cast<const bf16x8*>((const char*)Ks + KSWZ(32 + r32, cb));
        if (d0 == 0) { p0 = __builtin_amdgcn_mfma_f32_32x32x16_bf16(b0, qr[0], negm, 0, 0, 0); p1 = __builtin_amdgcn_mfma_f32_32x32x16_bf16(b1, qr[0], negm, 0, 0, 0); }
        else { p0 = __builtin_amdgcn_mfma_f32_32x32x16_bf16(b0, qr[d0], p0, 0, 0, 0); p1 = __builtin_amdgcn_mfma_f32_32x32x16_bf16(b1, qr[d0], p1, 0, 0, 0); } }
}
__device__ __forceinline__ int v_st(int k, int c) { const int kk = (k & ~0xC) | ((k & 4) << 1) | ((k & 8) >> 1); return ((kk >> 3) * 4 + (c >> 5)) * 512 + ((kk & 7) * 32 + (c & 31)) * 2; }
__device__ __forceinline__ int v_rd_base(int lane) { return ((lane & 3) << 3) | (((lane >> 2) & 3) << 6) | (((lane >> 4) & 1) << 5) | (((lane >> 5) & 1) << 8); }
constexpr int v_rd_off(int d0, int ks, int half) { return d0 * 512 + ks * 4096 + half * 2048; }
template <int OFF> __device__ __forceinline__ s16x4 tr_read(int vb) {
    s16x4 r; asm volatile("ds_read_b64_tr_b16 %0, %1 offset:%2" : "=&v"(r) : "v"(vb), "i"(OFF) : "memory"); return r;
}
template <int D0> __device__ __forceinline__ void pv_one(f32x16& od, int vb, bf16x8 pa0, bf16x8 pa1, bf16x8 pa2, bf16x8 pa3) {
    const s16x4 l0 = tr_read<v_rd_off(D0, 0, 0)>(vb), h0 = tr_read<v_rd_off(D0, 0, 1)>(vb), l1 = tr_read<v_rd_off(D0, 1, 0)>(vb), h1 = tr_read<v_rd_off(D0, 1, 1)>(vb);
    const s16x4 l2 = tr_read<v_rd_off(D0, 2, 0)>(vb), h2 = tr_read<v_rd_off(D0, 2, 1)>(vb), l3 = tr_read<v_rd_off(D0, 3, 0)>(vb), h3 = tr_read<v_rd_off(D0, 3, 1)>(vb);
    asm volatile("s_waitcnt lgkmcnt(0)" ::: "memory"); SBAR();
#define PK(L, H) (bf16x8){L[0], L[1], L[2], L[3], H[0], H[1], H[2], H[3]}
    od = __builtin_amdgcn_mfma_f32_32x32x16_bf16(pa0, PK(l0, h0), od, 0, 0, 0);
    od = __builtin_amdgcn_mfma_f32_32x32x16_bf16(pa1, PK(l1, h1), od, 0, 0, 0);
    od = __builtin_amdgcn_mfma_f32_32x32x16_bf16(pa2, PK(l2, h2), od, 0, 0, 0);
    od = __builtin_amdgcn_mfma_f32_32x32x16_bf16(pa3, PK(l3, h3), od, 0, 0, 0);
#undef PK
}
__device__ __forceinline__ void pv_d0(f32x16* o, int vb, bf16x8 pa0, bf16x8 pa1, bf16x8 pa2, bf16x8 pa3) {
    pv_one<0>(o[0], vb, pa0, pa1, pa2, pa3); pv_one<1>(o[1], vb, pa0, pa1, pa2, pa3); pv_one<2>(o[2], vb, pa0, pa1, pa2, pa3); pv_one<3>(o[3], vb, pa0, pa1, pa2, pa3);
}

constexpr int STG_ROW = 136;
constexpr int STG_WAVE = 32 * STG_ROW * 2;
__device__ __forceinline__ void stage_o(const f32x16* o, const float* rli, bf16_t* stg, int r32, int hi) {
#pragma unroll
    for (int r = 0; r < 16; ++r) { const int orow = crow(r, hi);
#pragma unroll
        for (int d0 = 0; d0 < 4; ++d0) stg[orow * STG_ROW + d0 * 32 + r32] = (bf16_t)f2bf(o[d0][r] * rli[r]); }
    asm volatile("s_waitcnt lgkmcnt(0)" ::: "memory");
}
struct EpiDil {
    bf16_t* O; float* lse; int RS;
    __device__ __forceinline__ void operator()(const f32x16* o, const float* rli, float l_reg, float m_reg, int wid, int lane, bf16_t* stg) const {
        asm volatile("" : "+v"(lane)); __builtin_assume(lane >= 0 && lane < 64);
        const int r32 = lane & 31, hi = lane >> 5;
        stage_o(o, rli, stg, r32, hi);
        bf16_t* Ow = O + (size_t)(wid * QBLK) * RS;
#pragma unroll
        for (int i = 0; i < 8; ++i) { const int row = i * 4 + (lane >> 4), ch = lane & 15;
            const u32x4 v = *(const u32x4*)(stg + row * STG_ROW + ch * 8); *(u32x4*)(Ow + (size_t)row * RS + ch * 8) = v; }
        if (hi == 0) lse[(wid * QBLK + r32) * (RS >> 7)] = (m_reg + __log2f(l_reg)) * 0.6931471805599453f;
    }
};
struct EpiGate {
    bf16_t* Y; const bf16_t* G;
    __device__ __forceinline__ void operator()(const f32x16* o, const float* rli, float l_reg, float m_reg, int wid, int lane, bf16_t* stg) const {
        asm volatile("" : "+v"(lane)); __builtin_assume(lane >= 0 && lane < 64);
        const int r32 = lane & 31, hi = lane >> 5;
        stage_o(o, rli, stg, r32, hi);
#pragma unroll
        for (int i = 0; i < 8; ++i) { const int row = i * 4 + (lane >> 4), ch = lane & 15; const size_t idx = (size_t)(wid * QBLK + row) * BRW + ch * 8;
            const bf16x8 gv = *(const bf16x8*)(G + idx); const bf16x8 ov = *(const bf16x8*)(stg + row * STG_ROW + ch * 8);
            float rr[8];
#pragma unroll
            for (int e = 0; e < 8; ++e) rr[e] = bf2f((unsigned short)ov[e]) * silu(bf2f((unsigned short)gv[e]));
            u32x4 w; w.x = pk2(rr[0], rr[1]); w.y = pk2(rr[2], rr[3]); w.z = pk2(rr[4], rr[5]); w.w = pk2(rr[6], rr[7]);
            *(u32x4*)(Y + idx) = w; }
    }
};

__device__ __forceinline__ void glds16s(unsigned voff, const void* sbase, unsigned lds_dst) { unsigned keep;
    asm volatile("s_mov_b32 %0, m0\n\ts_mov_b32 m0, %3\n\ts_nop 0\n\tglobal_load_lds_dwordx4 %1, %2\n\ts_mov_b32 m0, %0" : "=&s"(keep) : "v"(voff), "s"(sbase), "s"(lds_dst) : "memory"); }

template <bool MASK, class Epi>
__device__ __forceinline__ void attn_unit(const int tid, const bf16_t* Qb, const bf16_t* Kh, const bf16_t* Vh, int NT, int dq, char* lds, const Epi& E, const int rs_arg = D) {
    const int RS = MASK ? rs_arg : D;
    const int wid = __builtin_amdgcn_readfirstlane(tid >> 6), lane = tid & 63, r32 = lane & 31, hi = lane >> 5;
    constexpr int NSLOT = 4;
    bf16_t* V_lds = (bf16_t*)lds; bf16_t* K_lds = (bf16_t*)(lds + NSLOT * SHM_V);
    float* ws = (float*)(lds + NSLOT * SHM_V + NSLOT * SHM_K) + wid * 64; float* li_l = ws; float* al_l = ws + 32;
    float m_reg = 0.f, l_reg = 0; f32x16 o[4] = {}; bf16x8 qr[8];
    f32x16 negm = f32x16{};
    const bf16_t* Qw = Qb + (long)(wid * QBLK + r32) * RS + hi * 8;
#pragma unroll
    for (int d0 = 0; d0 < 8; ++d0) qr[d0] = *reinterpret_cast<const bf16x8*>(Qw + d0 * 16);
    const int vb0 = (int)(uintptr_t)V_lds + v_rd_base(lane);
    const int mb0 = dq + 4 * hi - (wid * QBLK + r32);
    unsigned kof[2], vof[2];
#pragma unroll
    for (int i = 0; i < 2; ++i) { const int p = wid * 2 + i;
        const int krow = p * 4 + (lane >> 4), kc = (lane & 15) ^ (krow & 7); kof[i] = (unsigned)(krow * RS * 2 + kc * 16);
        const int sub = p * 2 + (lane >> 5), kk = (sub >> 2) * 8 + ((lane & 31) >> 2), k = (kk & ~0xC) | ((kk & 4) << 1) | ((kk & 8) >> 1), c = (sub & 3) * 32 + 8 * (lane & 3);
        vof[i] = (unsigned)(k * RS * 2 + c * 2); }
    const unsigned ldsV = (unsigned)(uintptr_t)V_lds + (unsigned)wid * 2048u, ldsK = (unsigned)(uintptr_t)K_lds + (unsigned)wid * 2048u;
#define DMA_TILE(t, slot) do { const char* kt_ = (const char*)(Kh + (long)(t) * KVBLK * RS); const char* vt_ = (const char*)(Vh + (long)(t) * KVBLK * RS); \
    const unsigned so_ = (unsigned)(slot) * (unsigned)SHM_V; \
    glds16s(kof[0], kt_, (unsigned)__builtin_amdgcn_readfirstlane(ldsK + so_)); glds16s(kof[1], kt_, (unsigned)__builtin_amdgcn_readfirstlane(ldsK + so_ + 1024u)); \
    glds16s(vof[0], vt_, (unsigned)__builtin_amdgcn_readfirstlane(ldsV + so_)); glds16s(vof[1], vt_, (unsigned)__builtin_amdgcn_readfirstlane(ldsV + so_ + 1024u)); } while (0)
#define WAIT_BAR(N) do { asm volatile("s_waitcnt vmcnt(" #N ")" ::: "memory"); __syncthreads(); } while (0)
#define RESC(a) do { if (__any((a) < 1.f)) { if (hi == 0) al_l[r32] = (a); asm volatile("s_waitcnt lgkmcnt(0)" ::: "memory"); \
    _Pragma("unroll") for (int d = 0; d < 4; ++d) _Pragma("unroll") for (int r = 0; r < 16; ++r) o[d][r] *= al_l[crow(r, hi)]; } } while (0)
#define MSK(P0, P1, t) do { if (MASK) band_mask(P0, P1, mb0 + (t) * KVBLK); } while (0)
    f32x16 pA0, pA1, pB0, pB1; float mnA, mnB, alA, alB; bf16x8 pa0, pa1, pa2, pa3;
    const int widu = wid;
    if (widu >= 4) __builtin_amdgcn_s_setprio(1);
#define ACT(t) (!MASK || ((dq + (t) * KVBLK + 127 >= widu * QBLK) && (dq + (t) * KVBLK <= widu * QBLK + 95)))
    bool aA, aB;
    DMA_TILE(0, 0); DMA_TILE(1, 1); DMA_TILE(2, 2);
    WAIT_BAR(8);
    aA = ACT(0);
    if (aA) { qkt(pA0, pA1, K_lds, qr, negm, r32, hi); MSK(pA0, pA1, 0); partialSM<true>(pA0, pA1, m_reg, negm, alA); } else alA = 1.f;
    RESC(alA);
    WAIT_BAR(4);
    int sc_ = 1, sp_ = 0, sn_ = 2, sf_ = 3;
#define STEP(PC0, PC1, PP0, PP1, aC, aP, alC, alP, mnC, t) do { \
        const bool more_ = (t) + 2 < NT; if (more_) DMA_TILE((t) + 2, sf_); \
        aC = ACT(t); \
        SBAR(); if (aC) { qkt(PC0, PC1, (bf16_t*)((char*)K_lds + sc_ * SHM_K), qr, negm, r32, hi); MSK(PC0, PC1, t); } \
        if (aP) finishSM(PP0, PP1, alP, l_reg, pa0, pa1, pa2, pa3); SBAR(); \
        if (aP) pv_d0(o, vb0 + sp_ * (int)SHM_V, pa0, pa1, pa2, pa3); \
        if (aC) partialSM(PC0, PC1, m_reg, negm, alC); else alC = 1.f; \
        RESC(alC); \
        if (more_) { WAIT_BAR(4); } else { WAIT_BAR(0); }           \
        { const int t_ = sp_; sp_ = sc_; sc_ = sn_; sn_ = sf_; sf_ = t_; } } while (0)
    int j = 1;
    for (; j + 1 < NT; j += 2) {
        STEP(pB0, pB1, pA0, pA1, aB, aA, alB, alA, mnB, j);
        STEP(pA0, pA1, pB0, pB1, aA, aB, alA, alB, mnA, j + 1);
    }
    aB = ACT(NT - 1);
    SBAR(); if (aB) { qkt(pB0, pB1, (bf16_t*)((char*)K_lds + sc_ * SHM_K), qr, negm, r32, hi); MSK(pB0, pB1, NT - 1); }
    if (aA) finishSM(pA0, pA1, alA, l_reg, pa0, pa1, pa2, pa3); SBAR();
    if (aA) pv_d0(o, vb0 + sp_ * (int)SHM_V, pa0, pa1, pa2, pa3);
    if (aB) partialSM(pB0, pB1, m_reg, negm, alB); else alB = 1.f;
    RESC(alB);
    if (aB) { finishSM(pB0, pB1, alB, l_reg, pa0, pa1, pa2, pa3); SBAR();
        pv_d0(o, vb0 + sc_ * (int)SHM_V, pa0, pa1, pa2, pa3); }
#undef ACT
#undef STEP
    if (hi == 0) li_l[r32] = l_reg; asm volatile("s_waitcnt lgkmcnt(0)" ::: "memory");
    float rli[16];
#pragma unroll
    for (int r = 0; r < 16; ++r) rli[r] = __builtin_amdgcn_rcpf(li_l[crow(r, hi)]);
    __builtin_amdgcn_s_setprio(0);
    __syncthreads();
    E(o, rli, l_reg, m_reg, wid, lane, (bf16_t*)(lds + wid * STG_WAVE));
    __syncthreads();
#undef DMA_TILE
#undef WAIT_BAR
#undef RESC
#undef MSK
}
}

#define XB_TMO      128
#define XB_XCNT(j)  (256  + 64 * (j))
#define XB_XSUB(j)  (1280 + 64 * (j))
#define XB_XGEN(j)  (2304 + 64 * (j))
#define XB_TOP      3328
#define XB_TOPGEN   3392
#define XCD_BAR_WORDS 3456
#define XB_SPIN_CAP (1u << 18)
__device__ __forceinline__ unsigned xb_ld(unsigned* p)              { return __hip_atomic_load(p, __ATOMIC_RELAXED, __HIP_MEMORY_SCOPE_AGENT); }
__device__ __forceinline__ unsigned xb_add(unsigned* p, unsigned v) { return __hip_atomic_fetch_add(p, v, __ATOMIC_RELAXED, __HIP_MEMORY_SCOPE_AGENT); }
__device__ __forceinline__ unsigned xb_xcc_id() { return (unsigned)__builtin_amdgcn_s_getreg((3 << 11) | 20) & 0xFu; }
#define XB_SPIN(cond, bar) do { unsigned _sp = 0; while (cond) { __builtin_amdgcn_s_sleep(1); \
    if ((++_sp & 255u) == 0u) { if (xb_ld(&(bar)[XB_TMO])) break; if (_sp > XB_SPIN_CAP) { atomicAdd(&(bar)[XB_TMO], 1u); break; } } } } while (0)
struct XcdBarrier { unsigned* bar; unsigned x; volatile LAS unsigned* st; };
__device__ __forceinline__ XcdBarrier xcd_barrier_post(unsigned* bar, volatile LAS unsigned* st) {
    XcdBarrier b; b.bar = bar; b.x = xb_xcc_id(); b.st = st;
    if (threadIdx.x == 0) (void)xb_add(&bar[XB_XCNT(b.x)], 1u);
    return b;
}
__device__ __forceinline__ void xcd_barrier_complete(unsigned* bar, unsigned x, unsigned& nloc, unsigned& nx) {
    const unsigned G = gridDim.x * gridDim.y * gridDim.z;
    unsigned sum, cnt, mine, sp = 0u;
    for (;;) {
        sum = 0u; cnt = 0u; mine = 0u;
#pragma unroll
        for (unsigned j = 0; j < 16; ++j) { const unsigned c = xb_ld(&bar[XB_XCNT(j)]); sum += c; cnt += (c > 0u) ? 1u : 0u; mine = (j == x) ? c : mine; }
        if (sum == G) break;
        __builtin_amdgcn_s_sleep(1);
        if ((++sp & 255u) == 0u) { if (xb_ld(&bar[XB_TMO])) break; if (sp > XB_SPIN_CAP) { atomicAdd(&bar[XB_TMO], 1u); break; } }
    }
    nloc = mine > 0u ? mine : 1u; nx = cnt > 0u ? cnt : 1u;
}
__device__ __forceinline__ void xcd_barrier(const XcdBarrier& b, const int wave_s) {
    asm volatile("s_waitcnt vmcnt(0)" ::: "memory");
    __syncthreads();
    if (tid_now(wave_s) == 0) {
        unsigned* bar = b.bar;
        __builtin_amdgcn_s_waitcnt(0);
        unsigned nloc = b.st[0], nx = b.st[1];
        if (nloc == 0u) { xcd_barrier_complete(bar, b.x, nloc, nx); b.st[0] = nloc; b.st[1] = nx; }
        const unsigned old = xb_add(&bar[XB_XSUB(b.x)], 1u);
        const unsigned gen = old / nloc;
        if (old + 1u == (gen + 1u) * nloc) {
            __builtin_amdgcn_fence(__ATOMIC_RELEASE, "agent");
            asm volatile("s_waitcnt vmcnt(0)" ::: "memory");
            const unsigned og = xb_add(&bar[XB_TOP], 1u);
            const unsigned tg = og / nx;
            if (og + 1u == (tg + 1u) * nx) xb_add(&bar[XB_TOPGEN], 1u);
            else XB_SPIN(xb_ld(&bar[XB_TOPGEN]) == tg, bar);
            __builtin_amdgcn_fence(__ATOMIC_ACQUIRE, "agent");
            xb_add(&bar[XB_XGEN(b.x)], 1u);
            asm volatile("s_waitcnt vmcnt(0)" ::: "memory");
        } else {
            XB_SPIN(xb_ld(&bar[XB_XGEN(b.x)]) == gen, bar);
            __builtin_amdgcn_fence(__ATOMIC_ACQUIRE, "agent");
            asm volatile("s_waitcnt vmcnt(0)" ::: "memory");
        }
    }
    __syncthreads();
}

__device__ __forceinline__ float wave_sum(float v, int lane) {
#pragma unroll
    for (int o = 1; o < 64; o <<= 1) v += shfl_xor_l(v, o, lane);
    return v;
}
template <int PERMK> __device__ __forceinline__ int srccol(int n) {
    if (PERMK == 0) return n;
    const int hd = n >> 7, p = n & 127, pb = p >> 3, nn = (p >> 2) & 1, j = p & 3;
    if (PERMK == 1) { if (hd < 48 && p < 32) return hd * 128 + 4 * pb + j + 16 * nn; return n; }
    if (hd < 10) return hd * 128 + 4 * pb + j + 64 * nn; return n;
}
template <int PERMK>
__device__ __forceinline__ void transpose_item(const float* W, int K, int N, bf16_t* WT, int row_off, const float* gk, LAS float* scr, int item, int lane) {
    const int nblk = N / 32, kb = item / nblk, nb = item % nblk, k0 = 64 * kb, n0 = 32 * nb;
    const int src = srccol<PERMK>(n0 + 4 * (lane & 7));
#pragma unroll
    for (int i = 0; i < 8; ++i) { const int kk = 8 * i + (lane >> 3); f32x4 v = *(const f32x4*)(W + (size_t)(k0 + kk) * N + src); if (gk) v = v * gk[k0 + kk];
        LAS float* d = scr + kk * 33 + 4 * (lane & 7); d[0] = v.x; d[1] = v.y; d[2] = v.z; d[3] = v.w; }
    asm volatile("s_waitcnt lgkmcnt(0)" ::: "memory");
    const int c = lane & 7;
#pragma unroll
    for (int j = 0; j < 4; ++j) { const int n = (lane >> 3) + 8 * j; const LAS float* s = scr + (8 * c) * 33 + n;
        u32x4 o; o.x = pk2(s[0 * 33], s[1 * 33]); o.y = pk2(s[2 * 33], s[3 * 33]); o.z = pk2(s[4 * 33], s[5 * 33]); o.w = pk2(s[6 * 33], s[7 * 33]);
        *(u32x4*)(WT + (size_t)(row_off + n0 + n) * K + k0 + 8 * c) = o; }
    asm volatile("s_waitcnt lgkmcnt(0)" ::: "memory");
}
__device__ __forceinline__ void rms_row_to_bf16(const float* xrow, bf16_t* orow, int lane) {
    const f32x4* xr = (const f32x4*)xrow + lane;
    f32x4 v[4]; float s = 0.f;
#pragma unroll
    for (int j = 0; j < 4; ++j) { v[j] = xr[64 * j]; s += (v[j].x * v[j].x + v[j].y * v[j].y) + (v[j].z * v[j].z + v[j].w * v[j].w); }
    const float rstd = rsqrtf(wave_sum(s, lane) * (1.f / DM) + EPS);
    unsigned long long* o8 = (unsigned long long*)orow + lane;
#pragma unroll
    for (int j = 0; j < 4; ++j) o8[64 * j] = (unsigned long long)pk2(v[j].x * rstd, v[j].y * rstd) | ((unsigned long long)pk2(v[j].z * rstd, v[j].w * rstd) << 32);
}
__device__ __forceinline__ f32x2 cos_sin(double pos, double lntheta, double e) {
    const double ang = pos * exp(-e * lntheta);
    const double rev = ang * 0.15915494309189533577;
    const float fr = (float)(rev - rint(rev));
    return (f32x2){__builtin_amdgcn_cosf(fr), __builtin_amdgcn_sinf(fr)};
}

typedef const __attribute__((address_space(4))) unsigned char* kptr_t;
__device__ __forceinline__ kptr_t kargs() { kptr_t p = (kptr_t)__builtin_amdgcn_kernarg_segment_ptr(); asm volatile("" : "+s"(p)); return p; }
#define KARG(field) as_global(*(decltype(Params::field) const __attribute__((address_space(4)))*)(kb + offsetof(Params, field)))
#define PHASE_PTRS() kptr_t kb = kargs(); unsigned char* ws = KARG(ws); unsigned char* dob = (unsigned char*)KARG(out); \
    bf16_t* Wb_t = (bf16_t*)(ws + WS_WB); bf16_t* Wo_t = (bf16_t*)(ws + WS_WO); bf16_t* Wm_t = (bf16_t*)(ws + WS_WM); bf16_t* MKV = (bf16_t*)(ws + WS_MKV); \
    f32x2* tabA = (f32x2*)(ws + WS_TABA); f32x2* tabB = (f32x2*)(ws + WS_TABB); float* SS1 = (float*)(ws + WS_SS1); float* LSE = (float*)(ws + WS_LSE); \
    bf16_t* Y = (bf16_t*)(ws + WS_Y); bf16_t* R = (bf16_t*)(ws + WS_R); \
    bf16_t* A0 = (bf16_t*)(ws + WS_Y); bf16_t* Wa_t = (bf16_t*)(ws + WS_WA); bf16_t* memA = (bf16_t*)(ws + WS_MEMA); \
    (void)Wb_t; (void)Wo_t; (void)Wm_t; (void)MKV; (void)tabA; (void)tabB; (void)SS1; (void)LSE; (void)Y; (void)R; (void)A0; (void)Wa_t; (void)memA
template <class T> __device__ __forceinline__ T* launder(T* p) { __attribute__((address_space(1))) T* g_ = (__attribute__((address_space(1))) T*)p; asm volatile("" : "+s"(g_)); return (T*)g_; }
struct Params {
    const float *x, *mem, *norm_g, *mem_norm_g, *w_mem_kv, *mem_qn_g, *mem_kn_g, *w_out, *w_in_a, *qn_a, *kn_a, *w_in_b, *qn_b, *kn_b;
    float* out; unsigned char* ws;
};
constexpr int LDS_BYTES = 147456;

__global__ void __launch_bounds__(512) mega_fwd(Params P) {
    extern __shared__ __attribute__((aligned(16))) unsigned char lds[];
    cg::grid_group grid = cg::this_grid();
    LAS unsigned char* lds3 = (LAS unsigned char*)lds;
    const int tid = threadIdx.x, lane = tid & 63, wave = __builtin_amdgcn_readfirstlane(tid >> 6);
    const int G = gridDim.x, bx = blockIdx.x;
    volatile LAS unsigned* MISC = (volatile LAS unsigned*)(lds3 + LDS_BYTES - 64);
    if (tid < 16) MISC[tid] = 0u;
    __syncthreads();
    { kptr_t kb = kargs(); (void)xcd_barrier_post((unsigned*)(KARG(ws) + WS_BAR), MISC); }
#define GRID_BAR() do { kptr_t kb = kargs(); XcdBarrier b_; b_.bar = (unsigned*)(KARG(ws) + WS_BAR); b_.x = xb_xcc_id(); b_.st = (volatile LAS unsigned*)(lds3 + LDS_BYTES - 64); xcd_barrier(b_, wave); } while (0)
#ifndef P1_WGM
#define P1_WGM 8
#endif
#ifndef REP_P0
#define REP_P0 1
#endif
#ifndef REP_P1
#define REP_P1 1
#endif
#ifndef REP_P5
#define REP_P5 1
#endif
#ifndef REP_P6
#define REP_P6 1
#endif
#ifndef REP_P3
#define REP_P3 1
#endif
#ifndef REP_P4
#define REP_P4 1
#endif
#ifndef SKIP_P0
#pragma unroll 1
    for (int rep = 0; rep < REP_P0; ++rep) {
        PHASE_PTRS();
        const int t0 = tid_now(wave); const int lane = t0 & 63;
        LAS float* scr = (LAS float*)(lds3 + wave * 16384);
        const int gw = bx * 8 + wave, NGW = G * 8;
        constexpr int IA = (DM / 64) * (INA / 32), IB = (DM / 64) * (INB / 32), IO = (BRW / 64) * (DM / 32), IM = (DM / 64) * (DM / 32);
        constexpr int NITEMS = IA + IB + 2 * IO + 2 * IM;
        for (int it = gw; it < NITEMS; it += NGW) {
            int r = it;
            if (r < IA) { transpose_item<1>(KARG(w_in_a), DM, INA, Wa_t, 0, KARG(norm_g), scr, r, lane); continue; } r -= IA;
            if (r < IB) { transpose_item<2>(KARG(w_in_b), DM, INB, Wb_t, 0, KARG(norm_g) + DM, scr, r, lane); continue; } r -= IB;
            if (r < IO) { transpose_item<0>(KARG(w_out), BRW, DM, Wo_t, 0, nullptr, scr, r, lane); continue; } r -= IO;
            if (r < IO) { transpose_item<0>(KARG(w_out) + (size_t)BRW * DM, BRW, DM, Wo_t + (size_t)DM * BRW, 0, nullptr, scr, r, lane); continue; } r -= IO;
            if (r < IM) { transpose_item<0>(KARG(w_mem_kv), DM, DM, Wm_t, 0, KARG(mem_norm_g), scr, r, lane); continue; } r -= IM;
            transpose_item<0>(KARG(w_mem_kv) + (size_t)DM * DM, DM, DM, Wm_t, DM, KARG(mem_norm_g) + DM, scr, r, lane);
        }
        {
            const float* xin = KARG(x); const float* min_ = KARG(mem);
            for (int m0 = gw; m0 < NTOK + BATCH * NMEM; m0 += 4 * NGW) {
                f32x4 v[4][4]; float ss_[4];
#pragma unroll
                for (int q = 0; q < 4; ++q) { const int m = m0 + q * NGW; ss_[q] = 0.f;
                    if (m < NTOK + BATCH * NMEM) { const f32x4* xr = (const f32x4*)(m < NTOK ? xin + (size_t)m * DM : min_ + (size_t)(m - NTOK) * DM) + lane;
#pragma unroll
                        for (int j = 0; j < 4; ++j) v[q][j] = xr[64 * j]; } }
#pragma unroll
                for (int q = 0; q < 4; ++q) { const int m = m0 + q * NGW;
                    if (m < NTOK + BATCH * NMEM) {
#pragma unroll
                        for (int j = 0; j < 4; ++j) ss_[q] += (v[q][j].x * v[q][j].x + v[q][j].y * v[q][j].y) + (v[q][j].z * v[q][j].z + v[q][j].w * v[q][j].w);
                        const float rstd = rsqrtf(wave_sum(ss_[q], lane) * (1.f / DM) + EPS);
                        bf16_t* orow = (m < NTOK) ? A0 + (size_t)(m / CTOK) * ((size_t)CTOK * BRW) + (size_t)(m % CTOK) * DM : memA + (size_t)(m - NTOK) * DM;
                        unsigned long long* o8 = (unsigned long long*)orow + lane;
#pragma unroll
                        for (int j = 0; j < 4; ++j) o8[64 * j] = (unsigned long long)pk2(v[q][j].x * rstd, v[q][j].y * rstd) | ((unsigned long long)pk2(v[q][j].z * rstd, v[q][j].w * rstd) << 32); } }
            }
        }
        for (int idx = bx * 512 + t0; idx < SEQ * 80; idx += G * 512) {
            const int t = idx / 80, i = idx % 80;
            if (i < 16) tabA[t * 16 + i] = cos_sin((double)t, 13.122363377404328  , (double)i / 16.0);
            else { const int k = i - 16, f = k & 31; tabB[t * 64 + k] = cos_sin((double)(k < 32 ? (t >> 6) : (t & 63)), 9.210340371976184  , (double)f / 32.0); }
        }
    }
#endif
    grid.sync();

#ifndef SKIP_PM
    {
        PHASE_PTRS();
        pg8::Gemm g2{launder(memA), launder(Wm_t), BATCH * NMEM, 2 * DM, DM}; pg8::StaticOrder S2; S2.init(BATCH * NMEM, 2 * DM, G, bx);
        EpiHead<1> E2{launder(MKV), nullptr, launder(KARG(mem_kn_g)), nullptr, nullptr, nullptr};
        pg8::gemm_phase(wave, lds3, g2, S2, E2);
    }
#endif
#pragma unroll 1
    for (int ch = 0; ch < NCH; ++ch) {
#ifndef SKIP_P1
#pragma unroll 1
        for (int rep = 0; rep < REP_P1; ++rep) {
            PHASE_PTRS();
            pg8::Gemm g{launder(A0 + (size_t)ch * CTOK * BRW), launder(Wa_t), CTOK, INA, DM}; pg8::StaticOrder S; S.init(CTOK, INA, G, bx, P1_WGM);
            EpiHead<0> E{launder(R), launder(KARG(qn_a)), launder(KARG(kn_a)), launder(KARG(mem_qn_g)), nullptr, launder(tabA)};
            pg8::gemm_phase(wave, lds3, g, S, E);
        }
#endif
        GRID_BAR();
#ifndef SKIP_P2
        {
            PHASE_PTRS();
            const bf16_t* QKV = launder(R + R_QKV / 2); const bf16_t* GATE = launder(R + R_GATE0 / 2); const bf16_t* QM = launder(R + R_QM0 / 2);
#ifdef PROBE_P2
#pragma unroll 1
            for (int rep2 = 0; rep2 < 2; ++rep2)
#endif
#pragma unroll 1
            for (int u = bx; u < 1536; u += G) {
                {
                    int bl, gg, h, qb;
                    if (u < 1024) { qb = u & 15; h = (u >> 4) & 7; gg = (u >> 7) & 1; bl = u >> 8; }
                    else { const int v = u - 1024; qb = v & 15; h = (v >> 4) & 7; bl = v >> 7; gg = 2; }
                    const int dl = 2 * gg, L = SEQ >> dl, i0g = qb * 256, res = i0g / L, i0 = i0g % L, NT = (L == 256) ? 4 : 6;
                    int ks = i0 - 64; if (ks < 0) ks = 0; if (ks > L - 64 * NT) ks = L - 64 * NT;
                    const size_t hb = (size_t)((bl * 3 + 0) * 3 + gg) * 8 + h;
                    const int dd = 1 << dl;
                    const bf16_t* Qp = QKV + (hb * 4096 + res + (size_t)i0 * dd) * 128;
                    const bf16_t* Kp = QKV + ((hb + 24) * 4096 + res + (size_t)ks * dd) * 128;
                    const bf16_t* Vp = QKV + ((hb + 48) * 4096 + res + (size_t)ks * dd) * 128;
                    att::EpiDil E{(bf16_t*)Qp, LSE + ((size_t)((bl * 3 + gg) * 8 + h)) * 4096 + res + i0 * dd, 128 * dd};
#ifdef PROBE_P2
                    if (rep2) { E.O = (bf16_t*)(dob + 96 * MiB); E.lse = (float*)(dob + 97 * MiB); }
#endif
                    att::attn_unit<true>(tid_now(wave), Qp, Kp, Vp, NT, ks - i0, (char*)lds, E, 128 * dd);
                }
            }
#pragma unroll 1
            for (int u = 1536 + bx; u < 1792; u += G) {
                {
                    const int v = u - 1536, qb = v & 15, mh = (v >> 4) & 3, bl = v >> 6, b = ch * CB + bl;
                    const bf16_t* Qp = QM + ((size_t)(bl * 4 + mh) * 4096 + qb * 256) * 128;
                    const bf16_t* Kp = MKV + (size_t)(((0 * 2 + 0) * 8 + b) * 4 + mh) * 256 * 128;
                    const bf16_t* Vp = MKV + (size_t)(((0 * 2 + 1) * 8 + b) * 4 + mh) * 256 * 128;
                    const size_t tl = (size_t)bl * 4096 + qb * 256;
                    att::EpiGate E{Y + ((size_t)ch * CTOK + tl) * BRW + 1024 + mh * 128, GATE + tl * BRW + 1024 + mh * 128};
                    att::attn_unit<false>(tid_now(wave), Qp, Kp, Vp, 4, 0, (char*)lds, E);
                }
            }
        }
#endif
        GRID_BAR();
#ifndef SKIP_P3
#pragma unroll 1
        for (int rep = 0; rep < REP_P3; ++rep) {
            PHASE_PTRS();
            const bf16_t* QKV = launder(R + R_QKV / 2); const bf16_t* GATE = launder(R + R_GATE0 / 2);
            const int t3 = tid_now(wave);
            for (int it = bx * 512 + t3; it < CTOK * 128; it += G * 512) {
                const int c = it & 15, h = (it >> 4) & 7, tl = it >> 7, bl = tl >> 12, t = tl & 4095;
                float ls[3]; bf16x8 ov[3];
#pragma unroll
                for (int gg = 0; gg < 3; ++gg) { const int p = t;
                    const size_t hb = (size_t)((bl * 3 + 0) * 3 + gg) * 8 + h;
                    ls[gg] = LSE[((size_t)((bl * 3 + gg) * 8 + h)) * 4096 + p];
                    ov[gg] = *(const bf16x8*)(QKV + (hb * 4096 + p) * 128 + c * 8); }
                const float mx = fmaxf(ls[0], fmaxf(ls[1], ls[2]));
                float w0 = __expf(ls[0] - mx), w1 = __expf(ls[1] - mx), w2 = __expf(ls[2] - mx); const float inv = 1.f / (w0 + w1 + w2); w0 *= inv; w1 *= inv; w2 *= inv;
                const bf16x8 gv = *(const bf16x8*)(GATE + (size_t)tl * BRW + h * 128 + c * 8);
                float r[8];
#pragma unroll
                for (int e = 0; e < 8; ++e) { const float o = w0 * bf2f((unsigned short)ov[0][e]) + w1 * bf2f((unsigned short)ov[1][e]) + w2 * bf2f((unsigned short)ov[2][e]);
                    r[e] = o * silu(bf2f((unsigned short)gv[e])); }
                u32x4 w; w.x = pk2(r[0], r[1]); w.y = pk2(r[2], r[3]); w.z = pk2(r[4], r[5]); w.w = pk2(r[6], r[7]);
                *(u32x4*)(Y + ((size_t)ch * CTOK + tl) * BRW + h * 128 + c * 8) = w;
            }
        }
#endif
        GRID_BAR();
    }

#ifndef SKIP_P4
#pragma unroll 1
    for (int rep = 0; rep < REP_P4; ++rep) {
        PHASE_PTRS();
        pg8::Gemm g{launder(Y), launder(Wo_t), NTOK, DM, BRW}; pg8::StaticOrder S; S.init(NTOK, DM, G, bx);
        EpiRes<true> E{launder(KARG(x)), launder(KARG(out)), launder(R + R_A1 / 2), launder(SS1)};
        pg8::gemm_phase(wave, lds3, g, S, E);
    }
#endif
    GRID_BAR();
#ifndef SKIP_P5
#pragma unroll 1
    for (int rep = 0; rep < REP_P5; ++rep) {
        PHASE_PTRS();
        pg8::Gemm g{launder(R + R_A1 / 2), launder(Wb_t), NTOK, INB, DM}; pg8::StaticOrder S; S.init(NTOK, INB, G, bx);
        EpiHead<2> E{launder(R), launder(KARG(qn_b)), launder(KARG(kn_b)), launder(KARG(mem_qn_g) + HD), launder(SS1), launder(tabB)};
        pg8::gemm_phase(wave, lds3, g, S, E);
    }
#endif
    GRID_BAR();
#ifndef SKIP_P6
#pragma unroll 1
    for (int rep = 0; rep < REP_P6; ++rep) {
        PHASE_PTRS();
        const bf16_t* Q1 = launder(R + R_Q1 / 2); const bf16_t* K1 = launder(R + R_K1 / 2); const bf16_t* V1 = launder(R + R_V1 / 2); const bf16_t* QM1 = launder(R + R_QM1 / 2); const bf16_t* GATE1 = launder(R + R_GATE1 / 2);
#pragma unroll 1
        for (int u = bx; u < 1024; u += G) {
            {
                int qb = u & 15, h = (u >> 4) & 7, b = u >> 7;
                if (G == 256) {
                    const int x = bx & 7, j = bx >> 3, r = u >> 8, pair = x + 8 * (r >> 1), idx = (r & 1) * 32 + j;
                    b = pair >> 1; h = (pair & 1) * 4 + (idx >> 4); qb = idx & 15; }
                const bf16_t* Qp = Q1 + ((size_t)(b * 8 + h) * 4096 + qb * 256) * 128;
                const bf16_t* Kp = K1 + (size_t)(b * 2 + (h >> 2)) * 4096 * 128;
                const bf16_t* Vp = V1 + (size_t)(b * 2 + (h >> 2)) * 4096 * 128;
                const size_t tl = (size_t)b * 4096 + qb * 256;
                att::EpiGate E{Y + tl * BRW + h * 128, GATE1 + tl * BRW + h * 128};
                att::attn_unit<false>(tid_now(wave), Qp, Kp, Vp, 64, 0, (char*)lds, E);
            }
        }
#pragma unroll 1
        for (int u = 1024 + bx; u < 1536; u += G) {
            {
                const int v = u - 1024, qb = v & 15, mh = (v >> 4) & 3, b = v >> 6;
                const bf16_t* Qp = QM1 + ((size_t)(b * 4 + mh) * 4096 + qb * 256) * 128;
                const bf16_t* Kp = MKV + (size_t)(((1 * 2 + 0) * 8 + b) * 4 + mh) * 256 * 128;
                const bf16_t* Vp = MKV + (size_t)(((1 * 2 + 1) * 8 + b) * 4 + mh) * 256 * 128;
                const size_t tl = (size_t)b * 4096 + qb * 256;
                att::EpiGate E{Y + tl * BRW + 1024 + mh * 128, GATE1 + tl * BRW + 1024 + mh * 128};
                att::attn_unit<false>(tid_now(wave), Qp, Kp, Vp, 4, 0, (char*)lds, E);
            }
        }
    }
#endif
    GRID_BAR();
#ifndef SKIP_P7
    {
        PHASE_PTRS();
        pg8::Gemm g{launder(Y), launder(Wo_t + (size_t)DM * BRW), NTOK, DM, BRW}; pg8::StaticOrder S; S.init(NTOK, DM, G, bx);
        EpiRes<false> E{launder(KARG(out)), launder(KARG(out)), nullptr, nullptr};
        pg8::gemm_phase(wave, lds3, g, S, E);
    }
#endif
#ifdef PROBE_SYNC
#pragma unroll 1
    for (int i = 0; i < PROBE_SYNC; ++i) GRID_BAR();
#endif
#ifdef PROBE_GEMM
    GRID_BAR();
    {
        PHASE_PTRS();
        pg8::Gemm g{launder(Y), launder(Wb_t), NTOK, INB, DM}; pg8::StaticOrder S; S.init(NTOK, INB, G, bx);
        EpiPlain E{launder(R), INB};
        pg8::gemm_phase(wave, lds3, g, S, E);
    }
#endif
}

extern "C" void kernel_launch(void* const* d_in, const int* in_sizes, int n_in, void* d_out, int out_size, void* d_ws, size_t ws_size, hipStream_t stream) {
    static int grid = 0;
    if (grid == 0) {
        if (n_in != 14 || out_size != NTOK * DM || ws_size < WS_END2) { fprintf(stderr, "kernel_launch: unexpected shapes (n_in %d out %d ws %zu)\n", n_in, out_size, ws_size); grid = -1; return; }
        int dev = 0, cus = 0, per_cu = 0;
        if (hipGetDevice(&dev) != hipSuccess || hipDeviceGetAttribute(&cus, hipDeviceAttributeMultiprocessorCount, dev) != hipSuccess) { grid = -1; return; }
        if (hipFuncSetAttribute((const void*)mega_fwd, hipFuncAttributeMaxDynamicSharedMemorySize, LDS_BYTES) != hipSuccess) { fprintf(stderr, "kernel_launch: hipFuncSetAttribute failed\n"); grid = -1; return; }
        if (hipOccupancyMaxActiveBlocksPerMultiprocessor(&per_cu, (const void*)mega_fwd, 512, LDS_BYTES) != hipSuccess || per_cu < 1) { fprintf(stderr, "kernel_launch: occupancy query says %d\n", per_cu); grid = -1; return; }
        grid = cus;
    }
    if (grid < 0) return;
    if (hipMemsetAsync((char*)d_ws + WS_BAR, 0, XCD_BAR_WORDS * 4, stream) != hipSuccess) { fprintf(stderr, "kernel_launch: memset failed\n"); return; }
    Params p{};
    p.x = (const float*)d_in[0]; p.mem = (const float*)d_in[1]; p.norm_g = (const float*)d_in[2]; p.mem_norm_g = (const float*)d_in[3];
    p.w_mem_kv = (const float*)d_in[4]; p.mem_qn_g = (const float*)d_in[5]; p.mem_kn_g = (const float*)d_in[6]; p.w_out = (const float*)d_in[7];
    p.w_in_a = (const float*)d_in[8]; p.qn_a = (const float*)d_in[9]; p.kn_a = (const float*)d_in[10]; p.w_in_b = (const float*)d_in[11];
    p.qn_b = (const float*)d_in[12]; p.kn_b = (const float*)d_in[13]; p.out = (float*)d_out; p.ws = (unsigned char*)d_ws;
    void* args[] = {&p};
    hipError_t e = hipLaunchCooperativeKernel((const void*)mega_fwd, dim3(grid), dim3(512), args, LDS_BYTES, stream);
    if (e != hipSuccess) fprintf(stderr, "cooperative launch failed: %s (grid %d)\n", hipGetErrorString(e), grid);
}
```

```cpp
#include <hip/hip_runtime.h>
#include <hip/hip_cooperative_groups.h>
#include <cstdio>
#include <cstdint>
#include <cmath>
#include <cstddef>
namespace cg = cooperative_groups;

#define LAS __attribute__((address_space(3)))
typedef unsigned short bf16_t;
typedef short bf16x8 __attribute__((ext_vector_type(8)));
typedef short s16x4 __attribute__((ext_vector_type(4)));
typedef float f32x4 __attribute__((ext_vector_type(4)));
typedef float f32x2 __attribute__((ext_vector_type(2)));
typedef float f32x16 __attribute__((ext_vector_type(16)));
typedef unsigned u32x4 __attribute__((ext_vector_type(4)));

constexpr int BATCH = 8, SEQ = 4096, DM = 1024, NTOK = BATCH * SEQ;
constexpr int HD = 128, NMEM = 256;
constexpr int INA = 11264, INB = 3584, BRW = 1536;
constexpr int NCH = 2, CB = BATCH / NCH, CTOK = CB * SEQ;
constexpr float EPS = 1e-6f;
constexpr float SCALE = 0.088388347648318440f;

constexpr size_t MiB = 1u << 20;
constexpr size_t WS_WB = 0, WS_WO = 8 * MiB, WS_WM = 14 * MiB, WS_MKV = 18 * MiB, WS_TABA = 26 * MiB, WS_TABB = 27 * MiB, WS_SS1 = 29 * MiB, WS_LSE = 31 * MiB;
constexpr size_t WS_BAR = 33 * MiB;
constexpr size_t WS_Y = 34 * MiB, WS_R = 130 * MiB, WS_END = 482 * MiB;
constexpr size_t R_QKV = 0, R_GATE0 = 288 * MiB, R_QM0 = 336 * MiB;
constexpr size_t R_A1 = 0, R_Q1 = 64 * MiB, R_K1 = 128 * MiB, R_V1 = 144 * MiB, R_QM1 = 160 * MiB, R_GATE1 = 192 * MiB;
constexpr size_t WS_WA = 482 * MiB, WS_MEMA = 505 * MiB, WS_END2 = 509 * MiB;

__device__ __forceinline__ unsigned f2bf(float f) { unsigned u = __builtin_bit_cast(unsigned, f); return (u + 0x7fffu + ((u >> 16) & 1u)) >> 16; }
__device__ __forceinline__ unsigned pk2(float lo, float hi) { return f2bf(lo) | (f2bf(hi) << 16); }
__device__ __forceinline__ float bf2f(unsigned short b) { return __uint_as_float(((unsigned)b) << 16); }
__device__ __forceinline__ unsigned cvt_pk_bf16(float lo, float hi) { unsigned r; asm volatile("v_cvt_pk_bf16_f32 %0, %1, %2" : "=v"(r) : "v"(lo), "v"(hi)); return r; }
__device__ __forceinline__ int tid_now(int wave_s) { int l; asm volatile("v_mbcnt_lo_u32_b32 %0, -1, 0\n\tv_mbcnt_hi_u32_b32 %0, -1, %0" : "=v"(l)); l = (wave_s << 6) | l; __builtin_assume(l >= 0 && l < 512); return l; }
template <class T> __device__ __forceinline__ T* as_global(T* p) { return (T*)(__attribute__((address_space(1))) T*)p; }
__device__ __forceinline__ float shfl_xor_l(float v, int m, int lane) { return __int_as_float(__builtin_amdgcn_ds_bpermute((lane ^ m) << 2, __float_as_int(v))); }
__device__ __forceinline__ float silu(float g) { return g / (1.f + __expf(-g)); }

namespace pg8 {
constexpr int BM = 256, BK = 64, HALF = 128, HTB = HALF * BK * 2, STAGE_BYTES = 8 * HTB, NXCD = 8, WGM = 2;
__host__ __device__ __forceinline__ int lds_byte(int r, int c) { const int st = (r >> 4) * 2 + (c >> 5), rr = r & 15, cc = c & 31, ob = rr * 64 + cc * 2; return st * 1024 + (ob ^ (((ob >> 9) & 1) << 5)); }
__host__ __device__ __forceinline__ void stage_rc(int b, int& R, int& C) { const int st = b / 1024, sb = b % 1024, swz = sb ^ (((sb >> 9) & 1) << 5); R = (st >> 1) * 16 + swz / 64; C = (st & 1) * 32 + (swz % 64) / 2; }
__host__ __device__ __forceinline__ int perm32(int rho) { const int n = rho >> 4, i = rho & 15; return 8 * (i >> 2) + 4 * n + (i & 3); }
struct Unit { int pm, pn; };
struct Gemm { const bf16_t* A; const bf16_t* Bt; int M, N, K; };
struct StaticOrder {
    int nM, nN, nwg, G, c, wgm;
    __host__ __device__ void init(int M, int N, int G_, int c_, int wgm_ = WGM) { nM = M / BM; nN = N / BM; nwg = nM * nN; G = G_; c = c_; wgm = wgm_; }
    __host__ __device__ bool next(int i, Unit& u) const {
        const long L = (long)i * G + c; if (L >= nwg) return false;
        int wgid = (int)L; { const int q = nwg / NXCD, r = nwg % NXCD, xcd = wgid % NXCD, off = wgid / NXCD; wgid = (xcd < r ? xcd * (q + 1) : r * (q + 1) + (xcd - r) * q) + off; }
        const int nig = wgm * nN, gid = wgid / nig, fm = gid * wgm, gsz = (nM - fm) < wgm ? (nM - fm) : wgm;
        u.pm = fm + ((wgid % nig) % gsz); u.pn = (wgid % nig) / gsz; return true;
    }
};

template <class Epi>
__device__ __forceinline__ void gemm_phase(const int wave_s, LAS unsigned char* lds, const Gemm g, const StaticOrder& S, const Epi& E) {
    const int tid = tid_now(wave_s);
    int wid = wave_s; asm volatile("" : "+s"(wid));
    const int lane = tid & 63, wr = wid >> 2, wc = wid & 3, fr = lane & 15, fq = lane >> 4;
    const int K = g.K, nt = K / BK;
    unsigned voffA[2], voffB[2];
#pragma unroll
    for (int i = 0; i < 2; ++i) { int R, C; stage_rc(tid * 16 + i * 8192, R, C); const int Rb = (R & ~31) + perm32(R & 31);
        voffA[i] = (unsigned)(R * K + C) * 2u; voffB[i] = (unsigned)(Rb * K + C) * 2u; }
    const size_t kstep = (size_t)(BK * 2);
    const size_t hstep = (size_t)HALF * K * 2;
    const size_t tstep = 2 * hstep;
    const unsigned ldsw = (unsigned)wid * 1024u;
    const int aoff = lds_byte(wr * 64 + fr, fq * 8), boff = lds_byte(wc * 32 + fr, fq * 8);
#define PG8_SA(b, h) (((b) * 2 + (h)) * HTB)
#define PG8_SB(b, h) ((4 + (b) * 2 + (h)) * HTB)
#define PG8_STAGE(bufoff, gbase, voff) do { _Pragma("unroll") for (int _i = 0; _i < 2; ++_i) \
        __builtin_amdgcn_global_load_lds((const unsigned*)((const char*)(gbase) + (voff)[_i]), (LAS unsigned*)(lds + (bufoff) + ldsw + _i * 8192), 16, 0, 0); } while (0)
#define PG8_LDA(dst, b, h) do { _Pragma("unroll") for (int m = 0; m < 4; ++m) _Pragma("unroll") for (int k = 0; k < 2; ++k) dst[m][k] = *(const LAS bf16x8*)(lds + PG8_SA(b, h) + aoff + m * 2048 + k * 1024); } while (0)
#define PG8_LDB(dst, b, h) do { _Pragma("unroll") for (int n = 0; n < 2; ++n) _Pragma("unroll") for (int k = 0; k < 2; ++k) dst[n][k] = *(const LAS bf16x8*)(lds + PG8_SB(b, h) + boff + n * 2048 + k * 1024); } while (0)
#define PG8_MMA(ai, bj, At, Bt) do { __builtin_amdgcn_s_setprio(1); _Pragma("unroll") for (int m = 0; m < 4; ++m) _Pragma("unroll") for (int n = 0; n < 2; ++n) _Pragma("unroll") for (int k = 0; k < 2; ++k) \
        acc[ai][bj][m][n] = __builtin_amdgcn_mfma_f32_16x16x32_bf16(Bt[n][k], At[m][k], acc[ai][bj][m][n], 0, 0, 0); __builtin_amdgcn_s_setprio(0); } while (0)
#define PG8_WAIT_V(n) asm volatile("s_waitcnt vmcnt(" #n ")" ::: "memory")
#define PG8_WAIT_L(n) asm volatile("s_waitcnt lgkmcnt(" #n ")" ::: "memory")
#define PG8_BAR __builtin_amdgcn_s_barrier()
#define PG8_SCHED __builtin_amdgcn_sched_barrier(0)
    Unit cur, nxt; int ui = 0;
    if (!S.next(0, cur)) return;
    f32x4 acc[2][2][4][2];
#pragma unroll
    for (int a = 0; a < 2; ++a)
#pragma unroll
        for (int b = 0; b < 2; ++b)
#pragma unroll
            for (int m = 0; m < 4; ++m)
#pragma unroll
                for (int n = 0; n < 2; ++n) acc[a][b][m][n] = (f32x4){0.f, 0.f, 0.f, 0.f};
    bf16x8 At[4][2], B0[2][2], B1[2][2];
    const char* cA = (const char*)g.A + (size_t)cur.pm * tstep; const char* cB = (const char*)g.Bt + (size_t)cur.pn * tstep;
    PG8_STAGE(PG8_SB(0, 0), cB, voffB); PG8_STAGE(PG8_SB(0, 1), cB + hstep, voffB); PG8_STAGE(PG8_SA(0, 0), cA, voffA); PG8_STAGE(PG8_SA(0, 1), cA + hstep, voffA);
    if (wr == 1) PG8_BAR;
    PG8_WAIT_V(2); PG8_BAR;
    PG8_STAGE(PG8_SB(1, 0), cB + kstep, voffB); PG8_STAGE(PG8_SA(1, 0), cA + kstep, voffA); PG8_STAGE(PG8_SB(1, 1), cB + hstep + kstep, voffB);
    PG8_WAIT_V(6); PG8_BAR;
    for (;;) {
        const bool has_next = S.next(ui + 1, nxt);
        const char* nA = has_next ? (const char*)g.A + (size_t)nxt.pm * tstep : cA; const char* nB = has_next ? (const char*)g.Bt + (size_t)nxt.pn * tstep : cB;
        for (int t = 0; t < nt; t += 2) {
            const bool last = (t == nt - 2);
            const char* a1 = cA + (size_t)(t + 1) * kstep;
            const char* a2 = last ? nA : cA + (size_t)(t + 2) * kstep; const char* b2 = last ? nB : cB + (size_t)(t + 2) * kstep;
            const char* a3 = a2 + kstep; const char* b3 = b2 + kstep;
            PG8_LDB(B0, 0, 0); PG8_LDB(B1, 0, 1); PG8_SCHED; PG8_LDA(At, 0, 0); PG8_STAGE(PG8_SA(1, 1), a1 + hstep, voffA);
            PG8_WAIT_V(8); PG8_WAIT_L(0); PG8_BAR; PG8_MMA(0, 0, At, B0); PG8_MMA(0, 1, At, B1); PG8_BAR; PG8_SCHED;
            PG8_LDA(At, 0, 1); PG8_STAGE(PG8_SB(0, 0), b2, voffB); PG8_STAGE(PG8_SB(0, 1), b2 + hstep, voffB); PG8_STAGE(PG8_SA(0, 0), a2, voffA);
            PG8_WAIT_V(8); PG8_WAIT_L(0); PG8_BAR; PG8_MMA(1, 0, At, B0); PG8_MMA(1, 1, At, B1); PG8_BAR; PG8_SCHED;
            PG8_LDB(B0, 1, 0); PG8_LDB(B1, 1, 1); PG8_SCHED; PG8_LDA(At, 1, 0); PG8_STAGE(PG8_SA(0, 1), a2 + hstep, voffA);
            PG8_WAIT_V(8); PG8_WAIT_L(0); PG8_BAR; PG8_MMA(0, 0, At, B0); PG8_MMA(0, 1, At, B1); PG8_BAR; PG8_SCHED;
            PG8_LDA(At, 1, 1); PG8_STAGE(PG8_SB(1, 0), b3, voffB); PG8_STAGE(PG8_SB(1, 1), b3 + hstep, voffB); PG8_STAGE(PG8_SA(1, 0), a3, voffA);
            PG8_WAIT_V(8); PG8_WAIT_L(0); PG8_BAR; PG8_MMA(1, 0, At, B0); PG8_MMA(1, 1, At, B1); PG8_BAR; PG8_SCHED;
        }
        if (wr == 0) PG8_BAR;
        E(acc, cur, wr, wc, fr, fq, (LAS float*)(lds + STAGE_BYTES));
        if (!has_next) break;
#pragma unroll
        for (int a = 0; a < 2; ++a)
#pragma unroll
            for (int b = 0; b < 2; ++b)
#pragma unroll
                for (int m = 0; m < 4; ++m)
#pragma unroll
                    for (int n = 0; n < 2; ++n) acc[a][b][m][n] = (f32x4){0.f, 0.f, 0.f, 0.f};
        cur = nxt; cA = nA; cB = nB; ++ui;
        if (wr == 1) PG8_BAR;
    }
    PG8_WAIT_V(0);
    PG8_BAR;
#undef PG8_SA
#undef PG8_SB
#undef PG8_STAGE
#undef PG8_LDA
#undef PG8_LDB
#undef PG8_MMA
#undef PG8_WAIT_V
#undef PG8_WAIT_L
#undef PG8_BAR
#undef PG8_SCHED
}
}

template <int KIND> struct EpiHead {
    bf16_t* R;
    const float* gq; const float* gk; const float* gm;
    const float* ss;
    const f32x2* tab;
    __device__ __forceinline__ void operator()(f32x4 (&acc)[2][2][4][2], const pg8::Unit& u, int wr, int wc, int fr, int fq, LAS float* xl) const {
        int ln_;
        { const int t_ = tid_now(wr * 4 + wc); fr = t_ & 15; fq = (t_ >> 4) & 3; ln_ = t_ & 63; }
        const int rloc = wr * 64 + fr;
        const int rbase = u.pm * 256 + rloc;
        const int pb = wc * 4 + fq;
        bool norm[2], rowmajor[2], qsc[2]; const float* g[2]; bf16_t* base[2]; int bs[2], gcol[2]; int rope = 0, dl = 0, sh = 12;
#pragma unroll
        for (int bj = 0; bj < 2; ++bj) {
            const int hd = u.pn * 2 + bj; norm[bj] = false; rowmajor[bj] = false; g[bj] = nullptr; base[bj] = R; bs[bj] = 0; gcol[bj] = 0;
            qsc[bj] = (KIND == 0) ? (hd < 24 || (hd >= 72 && hd < 76)) : (KIND == 2) ? (hd < 8 || (hd >= 12 && hd < 16)) : false;
            if (KIND == 0) {
                if (hd < 72) { const int tsel = hd / 24, gg = (hd >> 3) % 3, h = hd & 7; norm[bj] = tsel < 2; if (tsel < 2) rope = 1; g[bj] = (tsel == 0 ? gq : gk) + gg * 128;
                    dl = 2 * gg; bs[bj] = 3 * 3 * 8 * 4096; base[bj] = R + (R_QKV / 2) + (size_t)((tsel * 3 + gg) * 8 + h) * 4096 * 128; }
                else if (hd < 76) { norm[bj] = true; g[bj] = gm; bs[bj] = 4 * 4096; base[bj] = R + (R_QM0 / 2) + (size_t)(hd - 72) * 4096 * 128; }
                else { rowmajor[bj] = true; gcol[bj] = (hd - 76) * 128; base[bj] = R + (R_GATE0 / 2); }
            } else if (KIND == 2) {
                if (hd < 8) { norm[bj] = true; rope = 2; g[bj] = gq; bs[bj] = 8 * 4096; base[bj] = R + (R_Q1 / 2) + (size_t)hd * 4096 * 128; }
                else if (hd < 10) { norm[bj] = true; rope = 2; g[bj] = gk; bs[bj] = 2 * 4096; base[bj] = R + (R_K1 / 2) + (size_t)(hd - 8) * 4096 * 128; }
                else if (hd < 12) { bs[bj] = 2 * 4096; base[bj] = R + (R_V1 / 2) + (size_t)(hd - 10) * 4096 * 128; }
                else if (hd < 16) { norm[bj] = true; g[bj] = gm; bs[bj] = 4 * 4096; base[bj] = R + (R_QM1 / 2) + (size_t)(hd - 12) * 4096 * 128; }
                else { rowmajor[bj] = true; gcol[bj] = (hd - 16) * 128; base[bj] = R + (R_GATE1 / 2); }
            } else {
                const int layer = hd >> 3, tt = (hd >> 2) & 1, mh = hd & 3; norm[bj] = tt == 0; g[bj] = gk + layer * 128; sh = 8; bs[bj] = 4 * 256;
                base[bj] = R + (size_t)(((layer * 2 + tt) * 8) * 4 + mh) * 256 * 128;
            }
        }
        const bool anynorm = norm[0] || norm[1];
        if (anynorm) {
#pragma unroll
        for (int ai = 0; ai < 2; ++ai)
#pragma unroll
            for (int m = 0; m < 4; ++m)
#pragma unroll
                for (int bj = 0; bj < 2; ++bj) {
                    const f32x4 a = acc[ai][bj][m][0], b = acc[ai][bj][m][1];
                    float s = (a.x * a.x + a.y * a.y) + (a.z * a.z + a.w * a.w) + (b.x * b.x + b.y * b.y) + (b.z * b.z + b.w * b.w);
                    s += shfl_xor_l(s, 16, ln_); s += shfl_xor_l(s, 32, ln_);
                    if (fq == 0) xl[((ai * 128 + m * 16 + rloc) * 2 + bj) * 4 + wc] = s;
                }
        }
        const int np = (rope == 2) ? 64 : 16;
        const bool dorope = (rope == 2) || (rope == 1 && pb < 4);
        f32x4 tc0 = (f32x4){1.f, 0.f, 1.f, 0.f}, tc1 = tc0;
        if (dorope) { const f32x4* tp = as_global((const f32x4*)(tab + (size_t)(rbase & 4095) * np + 4 * pb)); tc0 = tp[0]; tc1 = tp[1]; }
        float fac[2][4][2];
#pragma unroll
        for (int ai = 0; ai < 2; ++ai)
#pragma unroll
            for (int m = 0; m < 4; ++m) {
                float r_ = 1.f;
                if (KIND == 2) { const f32x4 a = *(const f32x4*)(ss + (size_t)(rbase + ai * 128 + m * 16) * 4); r_ = rsqrtf(((a.x + a.y) + (a.z + a.w)) * (1.0f / 1024.0f) + EPS); }
                fac[ai][m][0] = r_; fac[ai][m][1] = r_;
            }
        if (anynorm) { asm volatile("s_waitcnt lgkmcnt(0)" ::: "memory"); __builtin_amdgcn_s_barrier(); asm volatile("" ::: "memory"); }
#pragma unroll
        for (int ai = 0; ai < 2; ++ai)
#pragma unroll
            for (int m = 0; m < 4; ++m)
#pragma unroll
                for (int bj = 0; bj < 2; ++bj)
                    if (norm[bj]) {
                        const f32x4 pp = *(const LAS f32x4*)(xl + ((ai * 128 + m * 16 + rloc) * 2 + bj) * 4);
                        const float r_ = fac[ai][m][bj];
                        fac[ai][m][bj] = r_ * rsqrtf(((pp.x + pp.y) + (pp.z + pp.w)) * (r_ * r_) * (1.0f / 128.0f) + EPS);
                    }
        int dlo = pb * 8, dhi = pb * 8 + 4;
        if (rope == 1 && pb < 4) { dlo = 4 * pb; dhi = 16 + 4 * pb; }
        if (rope == 2) { dlo = 4 * pb; dhi = 64 + 4 * pb; }
        f32x4 g0[2], g1[2];
#pragma unroll
        for (int bj = 0; bj < 2; ++bj) { g0[bj] = (f32x4){1.f, 1.f, 1.f, 1.f}; g1[bj] = g0[bj]; if (norm[bj]) { g0[bj] = *(const f32x4*)(g[bj] + dlo); g1[bj] = *(const f32x4*)(g[bj] + dhi); } }
#pragma unroll
        for (int ai = 0; ai < 2; ++ai)
#pragma unroll
            for (int m = 0; m < 4; ++m) {
                const int row = rbase + ai * 128 + m * 16, t = row & ((1 << sh) - 1);
                const f32x4 c01 = tc0, c23 = tc1;
                if (dorope && (ai * 4 + m) < 7) {
                    const int nrow = rbase + ((ai * 4 + m + 1) >> 2) * 128 + ((ai * 4 + m + 1) & 3) * 16;
                    const f32x4* tp = as_global((const f32x4*)(tab + (size_t)(nrow & 4095) * np + 4 * pb)); tc0 = tp[0]; tc1 = tp[1]; }
                const f32x4 cs = (f32x4){c01.x, c01.z, c23.x, c23.z}, sn = (f32x4){c01.y, c01.w, c23.y, c23.w};
                const int p = t;
#pragma unroll
                for (int bj = 0; bj < 2; ++bj) {
                    const float f = qsc[bj] ? fac[ai][m][bj] * (SCALE * 1.4426950408889634f) : fac[ai][m][bj];
                    f32x4 v0 = acc[ai][bj][m][0] * f * g0[bj], v1 = acc[ai][bj][m][1] * f * g1[bj];
                    if (dorope) { const f32x4 o0 = v0 * cs - v1 * sn, o1 = v1 * cs + v0 * sn; v0 = o0; v1 = o1; }
                    u32x4 w; w.x = cvt_pk_bf16(v0[0], v0[1]); w.y = cvt_pk_bf16(v0[2], v0[3]); w.z = cvt_pk_bf16(v1[0], v1[1]); w.w = cvt_pk_bf16(v1[2], v1[3]);
                    bf16_t* dst;
                    if (rowmajor[bj]) dst = base[bj] + (size_t)row * BRW + gcol[bj] + pb * 8;
                    else dst = base[bj] + ((size_t)(row >> sh) * bs[bj] + p) * 128 + pb * 8;
                    *(u32x4*)dst = w;
                }
                asm volatile("" ::: "memory");
            }
    }
};

struct EpiPlain {
    bf16_t* O; int ldc;
    __device__ __forceinline__ void operator()(f32x4 (&acc)[2][2][4][2], const pg8::Unit& u, int wr, int wc, int fr, int fq, LAS float* xl) const {
        { const int t_ = tid_now(wr * 4 + wc); fr = t_ & 15; fq = (t_ >> 4) & 3; }
        const int rbase = u.pm * 256 + wr * 64 + fr, cbase = u.pn * 256 + wc * 32 + 8 * fq;
#pragma unroll
        for (int ai = 0; ai < 2; ++ai)
#pragma unroll
            for (int m = 0; m < 4; ++m)
#pragma unroll
                for (int bj = 0; bj < 2; ++bj) { const f32x4 v0 = acc[ai][bj][m][0], v1 = acc[ai][bj][m][1];
                    u32x4 w; w.x = cvt_pk_bf16(v0[0], v0[1]); w.y = cvt_pk_bf16(v0[2], v0[3]); w.z = cvt_pk_bf16(v1[0], v1[1]); w.w = cvt_pk_bf16(v1[2], v1[3]);
                    *(u32x4*)(O + (size_t)(rbase + ai * 128 + m * 16) * ldc + cbase + bj * 128) = w; }
    }
};
template <bool FIRST> struct EpiRes {
    const float* xi; float* xo; bf16_t* A1; float* ss;
    __device__ __forceinline__ void operator()(f32x4 (&acc)[2][2][4][2], const pg8::Unit& u, int wr, int wc, int fr, int fq, LAS float* xl) const {
        int ln_;
        { const int t_ = tid_now(wr * 4 + wc); fr = t_ & 15; fq = (t_ >> 4) & 3; ln_ = t_ & 63; }
        const int rbase = u.pm * 256 + wr * 64 + fr, cbase = u.pn * 256 + wc * 32 + 8 * fq;
#pragma unroll
        for (int ai = 0; ai < 2; ++ai)
#pragma unroll
            for (int m = 0; m < 4; ++m) {
                const int row = rbase + ai * 128 + m * 16; float s = 0.f;
#pragma unroll
                for (int bj = 0; bj < 2; ++bj) {
                    const size_t off = (size_t)row * DM + cbase + bj * 128;
                    const f32x4 xa = *(const f32x4*)(xi + off), xb = *(const f32x4*)(xi + off + 4);
                    const f32x4 v0 = acc[ai][bj][m][0] + xa, v1 = acc[ai][bj][m][1] + xb;
                    *(f32x4*)(xo + off) = v0; *(f32x4*)(xo + off + 4) = v1;
                    if (FIRST) {
                        u32x4 w; w.x = cvt_pk_bf16(v0[0], v0[1]); w.y = cvt_pk_bf16(v0[2], v0[3]); w.z = cvt_pk_bf16(v1[0], v1[1]); w.w = cvt_pk_bf16(v1[2], v1[3]);
                        *(u32x4*)(A1 + off) = w;
                        s += (v0.x * v0.x + v0.y * v0.y) + (v0.z * v0.z + v0.w * v0.w) + (v1.x * v1.x + v1.y * v1.y) + (v1.z * v1.z + v1.w * v1.w);
                    }
                }
                if (FIRST) { s += shfl_xor_l(s, 16, ln_); s += shfl_xor_l(s, 32, ln_); if (fq == 0) xl[(ai * 128 + m * 16 + wr * 64 + fr) * 4 + wc] = s; }
                asm volatile("" ::: "memory");
            }
        if (FIRST) {
            asm volatile("s_waitcnt lgkmcnt(0)" ::: "memory"); __builtin_amdgcn_s_barrier(); asm volatile("" ::: "memory");
            if (wc == 0 && fq == 0) {
#pragma unroll
                for (int ai = 0; ai < 2; ++ai)
#pragma unroll
                    for (int m = 0; m < 4; ++m) { const f32x4 pp = *(const LAS f32x4*)(xl + (ai * 128 + m * 16 + wr * 64 + fr) * 4);
                        ss[(size_t)(rbase + ai * 128 + m * 16) * 4 + u.pn] = (pp.x + pp.y) + (pp.z + pp.w); }
            }
        }
    }
};

namespace att {
constexpr int D = 128, NW = 8, QBLK = 32, KVBLK = 64;
constexpr float THR = 8.f;
#ifndef ATT_SDEPTH
#define ATT_SDEPTH 2
#endif
constexpr int SDEPTH = ATT_SDEPTH;
constexpr size_t SHM_V = KVBLK * D * 2, SHM_K = KVBLK * D * 2, SHM_ATTN = 2 * SHM_V + 2 * SHM_K + NW * 64 * 4;
#define KSWZ(row, colB) ((row) * 256 + ((colB) ^ (((row) & 7) << 4)))
#define SBAR() __builtin_amdgcn_sched_barrier(0)
__device__ __forceinline__ int crow(int r, int hi) { return (r & 3) + 8 * (r >> 2) + 4 * hi; }
__device__ __forceinline__ unsigned cvtpk(float lo, float hi) { unsigned r; asm volatile("v_cvt_pk_bf16_f32 %0, %1, %2" : "=v"(r) : "v"(lo), "v"(hi)); return r; }
__device__ __forceinline__ void band_mask(f32x16& p0, f32x16& p1, int base) {
#pragma unroll
    for (int r = 0; r < 16; ++r) { const int c = (r & 3) + 8 * (r >> 2);
        if ((unsigned)(base + c + 64) > 128u) p0[r] = -INFINITY;
        if ((unsigned)(base + c + 32 + 64) > 128u) p1[r] = -INFINITY; }
}
template <bool FIRST = false>
__device__ __forceinline__ void partialSM(f32x16& p0, f32x16& p1, float& mhat, f32x16& negm, float& alpha) {
    constexpr float THR2 = THR * 1.4426950408889634f;
    float pmax = p0[0];
#pragma unroll
    for (int r = 1; r < 16; ++r) pmax = fmaxf(pmax, p0[r]);
#pragma unroll
    for (int r = 0; r < 16; ++r) pmax = fmaxf(pmax, p1[r]);
    { auto rr = __builtin_amdgcn_permlane32_swap(__float_as_uint(pmax), __float_as_uint(pmax), false, false);
      pmax = fmaxf(__uint_as_float(rr[0]), __uint_as_float(rr[1])); }
    if (!FIRST && __builtin_expect(__all(pmax <= THR2), 1)) { alpha = 1.f; }
    else { const float dl = FIRST ? (pmax > -1e30f ? pmax : 0.f) : fmaxf(pmax, 0.f); mhat += dl; alpha = FIRST ? 1.f : __builtin_amdgcn_exp2f(-dl);
#pragma unroll
        for (int r = 0; r < 16; ++r) { p0[r] -= dl; p1[r] -= dl; }
#pragma unroll
        for (int r = 0; r < 16; ++r) negm[r] = -mhat; }
#pragma unroll
    for (int r = 0; r < 16; ++r) p0[r] = __builtin_amdgcn_exp2f(p0[r]);
}
__device__ __forceinline__ void finishSM(f32x16& p0, f32x16& p1, float alpha, float& l_reg, bf16x8& pa0, bf16x8& pa1, bf16x8& pa2, bf16x8& pa3) {
#pragma unroll
    for (int r = 0; r < 16; ++r) p1[r] = __builtin_amdgcn_exp2f(p1[r]);
    float ps = 0;
#pragma unroll
    for (int r = 0; r < 16; ++r) ps += p0[r];
#pragma unroll
    for (int r = 0; r < 16; ++r) ps += p1[r];
    { auto rr = __builtin_amdgcn_permlane32_swap(__float_as_uint(ps), __float_as_uint(ps), false, false);
      ps = __uint_as_float(rr[0]) + __uint_as_float(rr[1]); }
    l_reg = l_reg * alpha + ps;
#define PK4(P, BASE, OUT) do { unsigned a0 = cvtpk(P[BASE + 0], P[BASE + 1]), a1 = cvtpk(P[BASE + 2], P[BASE + 3]);   \
    unsigned b0 = cvtpk(P[BASE + 4], P[BASE + 5]), b1 = cvtpk(P[BASE + 6], P[BASE + 7]);                              \
    auto r0 = __builtin_amdgcn_permlane32_swap(a0, b0, false, false); auto r1 = __builtin_amdgcn_permlane32_swap(a1, b1, false, false); \
    u32x4 w = {r0[0], r1[0], r0[1], r1[1]}; OUT = *reinterpret_cast<bf16x8*>(&w); } while (0)
    PK4(p0, 0, pa0); PK4(p0, 8, pa1); PK4(p1, 0, pa2); PK4(p1, 8, pa3);
#undef PK4
}
__device__ __forceinline__ void qkt(f32x16& p0, f32x16& p1, const bf16_t* Ks, const bf16x8* qr, const f32x16& negm, int r32, int hi) {
#pragma unroll
    for (int d0 = 0; d0 < 8; ++d0) { int cb = (d0 * 16 + hi * 8) * 2;
        bf16x8 b0 = *reinterpret_cast<const bf16x8*>((const char*)Ks + KSWZ(r32, cb));
        bf16x8 b1 = *reinterpret_cast<const bf16x8*>((const char*)Ks + KSWZ(32 + r32, cb));
        if (d0 == 0) { p0 = __builtin_amdgcn_mfma_f32_32x32x16_bf16(b0, qr[0], negm, 0, 0, 0); p1 = __builtin_amdgcn_mfma_f32_32x32x16_bf16(b1, qr[0], negm, 0, 0, 0); }
        else { p0 = __builtin_amdgcn_mfma_f32_32x32x16_bf16(b0, qr[d0], p0, 0, 0, 0); p1 = __builtin_amdgcn_mfma_f32_32x32x16_bf16(b1, qr[d0], p1, 0, 0, 0); } }
}
__device__ __forceinline__ int v_st(int k, int c) { const int kk = (k & ~0xC) | ((k & 4) << 1) | ((k & 8) >> 1); return ((kk >> 3) * 4 + (c >> 5)) * 512 + ((kk & 7) * 32 + (c & 31)) * 2; }
__device__ __forceinline__ int v_rd_base(int lane) { return ((lane & 3) << 3) | (((lane >> 2) & 3) << 6) | (((lane >> 4) & 1) << 5) | (((lane >> 5) & 1) << 8); }
constexpr int v_rd_off(int d0, int ks, int half) { return d0 * 512 + ks * 4096 + half * 2048; }
template <int OFF> __device__ __forceinline__ s16x4 tr_read(int vb) {
    s16x4 r; asm volatile("ds_read_b64_tr_b16 %0, %1 offset:%2" : "=&v"(r) : "v"(vb), "i"(OFF) : "memory"); return r;
}
template <int D0> __device__ __forceinline__ void pv_one(f32x16& od, int vb, bf16x8 pa0, bf16x8 pa1, bf16x8 pa2, bf16x8 pa3) {
    const s16x4 l0 = tr_read<v_rd_off(D0, 0, 0)>(vb), h0 = tr_read<v_rd_off(D0, 0, 1)>(vb), l1 = tr_read<v_rd_off(D0, 1, 0)>(vb), h1 = tr_read<v_rd_off(D0, 1, 1)>(vb);
    const s16x4 l2 = tr_read<v_rd_off(D0, 2, 0)>(vb), h2 = tr_read<v_rd_off(D0, 2, 1)>(vb), l3 = tr_read<v_rd_off(D0, 3, 0)>(vb), h3 = tr_read<v_rd_off(D0, 3, 1)>(vb);
    asm volatile("s_waitcnt lgkmcnt(0)" ::: "memory"); SBAR();
#define PK(L, H) (bf16x8){L[0], L[1], L[2], L[3], H[0], H[1], H[2], H[3]}
    od = __builtin_amdgcn_mfma_f32_32x32x16_bf16(pa0, PK(l0, h0), od, 0, 0, 0);
    od = __builtin_amdgcn_mfma_f32_32x32x16_bf16(pa1, PK(l1, h1), od, 0, 0, 0);
    od = __builtin_amdgcn_mfma_f32_32x32x16_bf16(pa2, PK(l2, h2), od, 0, 0, 0);
    od = __builtin_amdgcn_mfma_f32_32x32x16_bf16(pa3, PK(l3, h3), od, 0, 0, 0);
#undef PK
}
__device__ __forceinline__ void pv_d0(f32x16* o, int vb, bf16x8 pa0, bf16x8 pa1, bf16x8 pa2, bf16x8 pa3) {
    pv_one<0>(o[0], vb, pa0, pa1, pa2, pa3); pv_one<1>(o[1], vb, pa0, pa1, pa2, pa3); pv_one<2>(o[2], vb, pa0, pa1, pa2, pa3); pv_one<3>(o[3], vb, pa0, pa1, pa2, pa3);
}

constexpr int STG_ROW = 136;
constexpr int STG_WAVE = 32 * STG_ROW * 2;
__device__ __forceinline__ void stage_o(const f32x16* o, const float* rli, bf16_t* stg, int r32, int hi) {
#pragma unroll
    for (int r = 0; r < 16; ++r) { const int orow = crow(r, hi);
#pragma unroll
        for (int d0 = 0; d0 < 4; ++d0) stg[orow * STG_ROW + d0 * 32 + r32] = (bf16_t)f2bf(o[d0][r] * rli[r]); }
    asm volatile("s_waitcnt lgkmcnt(0)" ::: "memory");
}
struct EpiDil {
    bf16_t* O; float* lse; int RS;
    __device__ __forceinline__ void operator()(const f32x16* o, const float* rli, float l_reg, float m_reg, int wid, int lane, bf16_t* stg) const {
        asm volatile("" : "+v"(lane)); __builtin_assume(lane >= 0 && lane < 64);
        const int r32 = lane & 31, hi = lane >> 5;
        stage_o(o, rli, stg, r32, hi);
        bf16_t* Ow = O + (size_t)(wid * QBLK) * RS;
#pragma unroll
        for (int i = 0; i < 8; ++i) { const int row = i * 4 + (lane >> 4), ch = lane & 15;
            const u32x4 v = *(const u32x4*)(stg + row * STG_ROW + ch * 8); *(u32x4*)(Ow + (size_t)row * RS + ch * 8) = v; }
        if (hi == 0) lse[(wid * QBLK + r32) * (RS >> 7)] = (m_reg + __log2f(l_reg)) * 0.6931471805599453f;
    }
};
struct EpiGate {
    bf16_t* Y; const bf16_t* G;
    __device__ __forceinline__ void operator()(const f32x16* o, const float* rli, float l_reg, float m_reg, int wid, int lane, bf16_t* stg) const {
        asm volatile("" : "+v"(lane)); __builtin_assume(lane >= 0 && lane < 64);
        const int r32 = lane & 31, hi = lane >> 5;
        stage_o(o, rli, stg, r32, hi);
#pragma unroll
        for (int i = 0; i < 8; ++i) { const int row = i * 4 + (lane >> 4), ch = lane & 15; const size_t idx = (size_t)(wid * QBLK + row) * BRW + ch * 8;
            const bf16x8 gv = *(const bf16x8*)(G + idx); const bf16x8 ov = *(const bf16x8*)(stg + row * STG_ROW + ch * 8);
            float rr[8];
#pragma unroll
            for (int e = 0; e < 8; ++e) rr[e] = bf2f((unsigned short)ov[e]) * silu(bf2f((unsigned short)gv[e]));
            u32x4 w; w.x = pk2(rr[0], rr[1]); w.y = pk2(rr[2], rr[3]); w.z = pk2(rr[4], rr[5]); w.w = pk2(rr[6], rr[7]);
            *(u32x4*)(Y + idx) = w; }
    }
};

__device__ __forceinline__ void glds16s(unsigned voff, const void* sbase, unsigned lds_dst) { unsigned keep;
    asm volatile("s_mov_b32 %0, m0\n\ts_mov_b32 m0, %3\n\ts_nop 0\n\tglobal_load_lds_dwordx4 %1, %2\n\ts_mov_b32 m0, %0" : "=&s"(keep) : "v"(voff), "s"(sbase), "s"(lds_dst) : "memory"); }

template <bool MASK, class Epi>
__device__ __forceinline__ void attn_unit(const int tid, const bf16_t* Qb, const bf16_t* Kh, const bf16_t* Vh, int NT, int dq, char* lds, const Epi& E, const int rs_arg = D) {
    const int RS = MASK ? rs_arg : D;
    const int wid = __builtin_amdgcn_readfirstlane(tid >> 6), lane = tid & 63, r32 = lane & 31, hi = lane >> 5;
    constexpr int NSLOT = 4;
    bf16_t* V_lds = (bf16_t*)lds; bf16_t* K_lds = (bf16_t*)(lds + NSLOT * SHM_V);
    float* ws = (float*)(lds + NSLOT * SHM_V + NSLOT * SHM_K) + wid * 64; float* li_l = ws; float* al_l = ws + 32;
    float m_reg = 0.f, l_reg = 0; f32x16 o[4] = {}; bf16x8 qr[8];
    f32x16 negm = f32x16{};
    const bf16_t* Qw = Qb + (long)(wid * QBLK + r32) * RS + hi * 8;
#pragma unroll
    for (int d0 = 0; d0 < 8; ++d0) qr[d0] = *reinterpret_cast<const bf16x8*>(Qw + d0 * 16);
    const int vb0 = (int)(uintptr_t)V_lds + v_rd_base(lane);
    const int mb0 = dq + 4 * hi - (wid * QBLK + r32);
    unsigned kof[2], vof[2];
#pragma unroll
    for (int i = 0; i < 2; ++i) { const int p = wid * 2 + i;
        const int krow = p * 4 + (lane >> 4), kc = (lane & 15) ^ (krow & 7); kof[i] = (unsigned)(krow * RS * 2 + kc * 16);
        const int sub = p * 2 + (lane >> 5), kk = (sub >> 2) * 8 + ((lane & 31) >> 2), k = (kk & ~0xC) | ((kk & 4) << 1) | ((kk & 8) >> 1), c = (sub & 3) * 32 + 8 * (lane & 3);
        vof[i] = (unsigned)(k * RS * 2 + c * 2); }
    const unsigned ldsV = (unsigned)(uintptr_t)V_lds + (unsigned)wid * 2048u, ldsK = (unsigned)(uintptr_t)K_lds + (unsigned)wid * 2048u;
#define DMA_TILE(t, slot) do { const char* kt_ = (const char*)(Kh + (long)(t) * KVBLK * RS); const char* vt_ = (const char*)(Vh + (long)(t) * KVBLK * RS); \
    const unsigned so_ = (unsigned)(slot) * (unsigned)SHM_V; \
    glds16s(kof[0], kt_, (unsigned)__builtin_amdgcn_readfirstlane(ldsK + so_)); glds16s(kof[1], kt_, (unsigned)__builtin_amdgcn_readfirstlane(ldsK + so_ + 1024u)); \
    glds16s(vof[0], vt_, (unsigned)__builtin_amdgcn_readfirstlane(ldsV + so_)); glds16s(vof[1], vt_, (unsigned)__builtin_amdgcn_readfirstlane(ldsV + so_ + 1024u)); } while (0)
#define WAIT_BAR(N) do { asm volatile("s_waitcnt vmcnt(" #N ")" ::: "memory"); __syncthreads(); } while (0)
#define RESC(a) do { if (__any((a) < 1.f)) { if (hi == 0) al_l[r32] = (a); asm volatile("s_waitcnt lgkmcnt(0)" ::: "memory"); \
    _Pragma("unroll") for (int d = 0; d < 4; ++d) _Pragma("unroll") for (int r = 0; r < 16; ++r) o[d][r] *= al_l[crow(r, hi)]; } } while (0)
#define MSK(P0, P1, t) do { if (MASK) band_mask(P0, P1, mb0 + (t) * KVBLK); } while (0)
    f32x16 pA0, pA1, pB0, pB1; float mnA, mnB, alA, alB; bf16x8 pa0, pa1, pa2, pa3;
    const int widu = wid;
    if (widu >= 4) __builtin_amdgcn_s_setprio(1);
#define ACT(t) (!MASK || ((dq + (t) * KVBLK + 127 >= widu * QBLK) && (dq + (t) * KVBLK <= widu * QBLK + 95)))
    bool aA, aB;
    DMA_TILE(0, 0); DMA_TILE(1, 1); DMA_TILE(2, 2);
    WAIT_BAR(8);
    aA = ACT(0);
    if (aA) { qkt(pA0, pA1, K_lds, qr, negm, r32, hi); MSK(pA0, pA1, 0); partialSM<true>(pA0, pA1, m_reg, negm, alA); } else alA = 1.f;
    RESC(alA);
    WAIT_BAR(4);
    int sc_ = 1, sp_ = 0, sn_ = 2, sf_ = 3;
#define STEP(PC0, PC1, PP0, PP1, aC, aP, alC, alP, mnC, t) do { \
        const bool more_ = (t) + 2 < NT; if (more_) DMA_TILE((t) + 2, sf_); \
        aC = ACT(t); \
        SBAR(); if (aC) { qkt(PC0, PC1, (bf16_t*)((char*)K_lds + sc_ * SHM_K), qr, negm, r32, hi); MSK(PC0, PC1, t); } \
        if (aP) finishSM(PP0, PP1, alP, l_reg, pa0, pa1, pa2, pa3); SBAR(); \
        if (aP) pv_d0(o, vb0 + sp_ * (int)SHM_V, pa0, pa1, pa2, pa3); \
        if (aC) partialSM(PC0, PC1, m_reg, negm, alC); else alC = 1.f; \
        RESC(alC); \
        if (more_) { WAIT_BAR(4); } else { WAIT_BAR(0); }           \
        { const int t_ = sp_; sp_ = sc_; sc_ = sn_; sn_ = sf_; sf_ = t_; } } while (0)
    int j = 1;
    for (; j + 1 < NT; j += 2) {
        STEP(pB0, pB1, pA0, pA1, aB, aA, alB, alA, mnB, j);
        STEP(pA0, pA1, pB0, pB1, aA, aB, alA, alB, mnA, j + 1);
    }
    aB = ACT(NT - 1);
    SBAR(); if (aB) { qkt(pB0, pB1, (bf16_t*)((char*)K_lds + sc_ * SHM_K), qr, negm, r32, hi); MSK(pB0, pB1, NT - 1); }
    if (aA) finishSM(pA0, pA1, alA, l_reg, pa0, pa1, pa2, pa3); SBAR();
    if (aA) pv_d0(o, vb0 + sp_ * (int)SHM_V, pa0, pa1, pa2, pa3);
    if (aB) partialSM(pB0, pB1, m_reg, negm, alB); else alB = 1.f;
    RESC(alB);
    if (aB) { finishSM(pB0, pB1, alB, l_reg, pa0, pa1, pa2, pa3); SBAR();
        pv_d0(o, vb0 + sc_ * (int)SHM_V, pa0, pa1, pa2, pa3); }
#undef ACT
#undef STEP
    if (hi == 0) li_l[r32] = l_reg; asm volatile("s_waitcnt lgkmcnt(0)" ::: "memory");
    float rli[16];
#pragma unroll
    for (int r = 0; r < 16; ++r) rli[r] = __builtin_amdgcn_rcpf(li_l[crow(r, hi)]);
    __builtin_amdgcn_s_setprio(0);
    __syncthreads();
    E(o, rli, l_reg, m_reg, wid, lane, (bf16_t*)(lds + wid * STG_WAVE));
    __syncthreads();
#undef DMA_TILE
#undef WAIT_BAR
#undef RESC
#undef MSK
}
}

#define XB_TMO      128
#define XB_XCNT(j)  (256  + 64 * (j))
#define XB_XSUB(j)  (1280 + 64 * (j))
#define XB_XGEN(j)  (2304 + 64 * (j))
#define XB_TOP      3328
#define XB_TOPGEN   3392
#define XCD_BAR_WORDS 3456
#define XB_SPIN_CAP (1u << 18)
__device__ __forceinline__ unsigned xb_ld(unsigned* p)              { return __hip_atomic_load(p, __ATOMIC_RELAXED, __HIP_MEMORY_SCOPE_AGENT); }
__device__ __forceinline__ unsigned xb_add(unsigned* p, unsigned v) { return __hip_atomic_fetch_add(p, v, __ATOMIC_RELAXED, __HIP_MEMORY_SCOPE_AGENT); }
__device__ __forceinline__ unsigned xb_xcc_id() { return (unsigned)__builtin_amdgcn_s_getreg((3 << 11) | 20) & 0xFu; }
#define XB_SPIN(cond, bar) do { unsigned _sp = 0; while (cond) { __builtin_amdgcn_s_sleep(1); \
    if ((++_sp & 255u) == 0u) { if (xb_ld(&(bar)[XB_TMO])) break; if (_sp > XB_SPIN_CAP) { atomicAdd(&(bar)[XB_TMO], 1u); break; } } } } while (0)
struct XcdBarrier { unsigned* bar; unsigned x; volatile LAS unsigned* st; };
__device__ __forceinline__ XcdBarrier xcd_barrier_post(unsigned* bar, volatile LAS unsigned* st) {
    XcdBarrier b; b.bar = bar; b.x = xb_xcc_id(); b.st = st;
    if (threadIdx.x == 0) (void)xb_add(&bar[XB_XCNT(b.x)], 1u);
    return b;
}
__device__ __forceinline__ void xcd_barrier_complete(unsigned* bar, unsigned x, unsigned& nloc, unsigned& nx) {
    const unsigned G = gridDim.x * gridDim.y * gridDim.z;
    unsigned sum, cnt, mine, sp = 0u;
    for (;;) {
        sum = 0u; cnt = 0u; mine = 0u;
#pragma unroll
        for (unsigned j = 0; j < 16; ++j) { const unsigned c = xb_ld(&bar[XB_XCNT(j)]); sum += c; cnt += (c > 0u) ? 1u : 0u; mine = (j == x) ? c : mine; }
        if (sum == G) break;
        __builtin_amdgcn_s_sleep(1);
        if ((++sp & 255u) == 0u) { if (xb_ld(&bar[XB_TMO])) break; if (sp > XB_SPIN_CAP) { atomicAdd(&bar[XB_TMO], 1u); break; } }
    }
    nloc = mine > 0u ? mine : 1u; nx = cnt > 0u ? cnt : 1u;
}
__device__ __forceinline__ void xcd_barrier(const XcdBarrier& b, const int wave_s) {
    asm volatile("s_waitcnt vmcnt(0)" ::: "memory");
    __syncthreads();
    if (tid_now(wave_s) == 0) {
        unsigned* bar = b.bar;
        __builtin_amdgcn_s_waitcnt(0);
        unsigned nloc = b.st[0], nx = b.st[1];
        if (nloc == 0u) { xcd_barrier_complete(bar, b.x, nloc, nx); b.st[0] = nloc; b.st[1] = nx; }
        const unsigned old = xb_add(&bar[XB_XSUB(b.x)], 1u);
        const unsigned gen = old / nloc;
        if (old + 1u == (gen + 1u) * nloc) {
            __builtin_amdgcn_fence(__ATOMIC_RELEASE, "agent");
            asm volatile("s_waitcnt vmcnt(0)" ::: "memory");
            const unsigned og = xb_add(&bar[XB_TOP], 1u);
            const unsigned tg = og / nx;
            if (og + 1u == (tg + 1u) * nx) xb_add(&bar[XB_TOPGEN], 1u);
            else XB_SPIN(xb_ld(&bar[XB_TOPGEN]) == tg, bar);
            __builtin_amdgcn_fence(__ATOMIC_ACQUIRE, "agent");
            xb_add(&bar[XB_XGEN(b.x)], 1u);
            asm volatile("s_waitcnt vmcnt(0)" ::: "memory");
        } else {
            XB_SPIN(xb_ld(&bar[XB_XGEN(b.x)]) == gen, bar);
            __builtin_amdgcn_fence(__ATOMIC_ACQUIRE, "agent");
            asm volatile("s_waitcnt vmcnt(0)" ::: "memory");
        }
    }
    __syncthreads();
}

__device__ __forceinline__ float wave_sum(float v, int lane) {
#pragma unroll
    for (int o = 1; o < 64; o <<= 1) v += shfl_xor_l(v, o, lane);
    return v;
}
template <int PERMK> __device__ __forceinline__ int srccol(int n) {
    if (PERMK == 0) return n;
    const int hd = n >> 7, p = n & 127, pb = p >> 3, nn = (p >> 2) & 1, j = p & 3;
    if (PERMK == 1) { if (hd < 48 && p < 32) return hd * 128 + 4 * pb + j + 16 * nn; return n; }
    if (hd < 10) return hd * 128 + 4 * pb + j + 64 * nn; return n;
}
template <int PERMK>
__device__ __forceinline__ void transpose_item(const float* W, int K, int N, bf16_t* WT, int row_off, const float* gk, LAS float* scr, int item, int lane) {
    const int nblk = N / 32, kb = item / nblk, nb = item % nblk, k0 = 64 * kb, n0 = 32 * nb;
    const int src = srccol<PERMK>(n0 + 4 * (lane & 7));
#pragma unroll
    for (int i = 0; i < 8; ++i) { const int kk = 8 * i + (lane >> 3); f32x4 v = *(const f32x4*)(W + (size_t)(k0 + kk) * N + src); if (gk) v = v * gk[k0 + kk];
        LAS float* d = scr + kk * 33 + 4 * (lane & 7); d[0] = v.x; d[1] = v.y; d[2] = v.z; d[3] = v.w; }
    asm volatile("s_waitcnt lgkmcnt(0)" ::: "memory");
    const int c = lane & 7;
#pragma unroll
    for (int j = 0; j < 4; ++j) { const int n = (lane >> 3) + 8 * j; const LAS float* s = scr + (8 * c) * 33 + n;
        u32x4 o; o.x = pk2(s[0 * 33], s[1 * 33]); o.y = pk2(s[2 * 33], s[3 * 33]); o.z = pk2(s[4 * 33], s[5 * 33]); o.w = pk2(s[6 * 33], s[7 * 33]);
        *(u32x4*)(WT + (size_t)(row_off + n0 + n) * K + k0 + 8 * c) = o; }
    asm volatile("s_waitcnt lgkmcnt(0)" ::: "memory");
}
__device__ __forceinline__ void rms_row_to_bf16(const float* xrow, bf16_t* orow, int lane) {
    const f32x4* xr = (const f32x4*)xrow + lane;
    f32x4 v[4]; float s = 0.f;
#pragma unroll
    for (int j = 0; j < 4; ++j) { v[j] = xr[64 * j]; s += (v[j].x * v[j].x + v[j].y * v[j].y) + (v[j].z * v[j].z + v[j].w * v[j].w); }
    const float rstd = rsqrtf(wave_sum(s, lane) * (1.f / DM) + EPS);
    unsigned long long* o8 = (unsigned long long*)orow + lane;
#pragma unroll
    for (int j = 0; j < 4; ++j) o8[64 * j] = (unsigned long long)pk2(v[j].x * rstd, v[j].y * rstd) | ((unsigned long long)pk2(v[j].z * rstd, v[j].w * rstd) << 32);
}
__device__ __forceinline__ f32x2 cos_sin(double pos, double lntheta, double e) {
    const double ang = pos * exp(-e * lntheta);
    const double rev = ang * 0.15915494309189533577;
    const float fr = (float)(rev - rint(rev));
    return (f32x2){__builtin_amdgcn_cosf(fr), __builtin_amdgcn_sinf(fr)};
}

typedef const __attribute__((address_space(4))) unsigned char* kptr_t;
__device__ __forceinline__ kptr_t kargs() { kptr_t p = (kptr_t)__builtin_amdgcn_kernarg_segment_ptr(); asm volatile("" : "+s"(p)); return p; }
#define KARG(field) as_global(*(decltype(Params::field) const __attribute__((address_space(4)))*)(kb + offsetof(Params, field)))
#define PHASE_PTRS() kptr_t kb = kargs(); unsigned char* ws = KARG(ws); unsigned char* dob = (unsigned char*)KARG(out); \
    bf16_t* Wb_t = (bf16_t*)(ws + WS_WB); bf16_t* Wo_t = (bf16_t*)(ws + WS_WO); bf16_t* Wm_t = (bf16_t*)(ws + WS_WM); bf16_t* MKV = (bf16_t*)(ws + WS_MKV); \
    f32x2* tabA = (f32x2*)(ws + WS_TABA); f32x2* tabB = (f32x2*)(ws + WS_TABB); float* SS1 = (float*)(ws + WS_SS1); float* LSE = (float*)(ws + WS_LSE); \
    bf16_t* Y = (bf16_t*)(ws + WS_Y); bf16_t* R = (bf16_t*)(ws + WS_R); \
    bf16_t* A0 = (bf16_t*)(ws + WS_Y); bf16_t* Wa_t = (bf16_t*)(ws + WS_WA); bf16_t* memA = (bf16_t*)(ws + WS_MEMA); \
    (void)Wb_t; (void)Wo_t; (void)Wm_t; (void)MKV; (void)tabA; (void)tabB; (void)SS1; (void)LSE; (void)Y; (void)R; (void)A0; (void)Wa_t; (void)memA
template <class T> __device__ __forceinline__ T* launder(T* p) { __attribute__((address_space(1))) T* g_ = (__attribute__((address_space(1))) T*)p; asm volatile("" : "+s"(g_)); return (T*)g_; }
struct Params {
    const float *x, *mem, *norm_g, *mem_norm_g, *w_mem_kv, *mem_qn_g, *mem_kn_g, *w_out, *w_in_a, *qn_a, *kn_a, *w_in_b, *qn_b, *kn_b;
    float* out; unsigned char* ws;
};
constexpr int LDS_BYTES = 147456;

__global__ void __launch_bounds__(512) mega_fwd(Params P) {
    extern __shared__ __attribute__((aligned(16))) unsigned char lds[];
    cg::grid_group grid = cg::this_grid();
    LAS unsigned char* lds3 = (LAS unsigned char*)lds;
    const int tid = threadIdx.x, lane = tid & 63, wave = __builtin_amdgcn_readfirstlane(tid >> 6);
    const int G = gridDim.x, bx = blockIdx.x;
    volatile LAS unsigned* MISC = (volatile LAS unsigned*)(lds3 + LDS_BYTES - 64);
    if (tid < 16) MISC[tid] = 0u;
    __syncthreads();
    { kptr_t kb = kargs(); (void)xcd_barrier_post((unsigned*)(KARG(ws) + WS_BAR), MISC); }
#define GRID_BAR() do { kptr_t kb = kargs(); XcdBarrier b_; b_.bar = (unsigned*)(KARG(ws) + WS_BAR); b_.x = xb_xcc_id(); b_.st = (volatile LAS unsigned*)(lds3 + LDS_BYTES - 64); xcd_barrier(b_, wave); } while (0)
#ifndef P1_WGM
#define P1_WGM 2
#endif
#ifndef REP_P0
#define REP_P0 1
#endif
#ifndef REP_P1
#define REP_P1 1
#endif
#ifndef REP_P5
#define REP_P5 1
#endif
#ifndef REP_P6
#define REP_P6 1
#endif
#ifndef REP_P3
#define REP_P3 1
#endif
#ifndef REP_P4
#define REP_P4 1
#endif
#ifndef SKIP_P0
#pragma unroll 1
    for (int rep = 0; rep < REP_P0; ++rep) {
        PHASE_PTRS();
        const int t0 = tid_now(wave); const int lane = t0 & 63;
        LAS float* scr = (LAS float*)(lds3 + wave * 16384);
        const int gw = bx * 8 + wave, NGW = G * 8;
        constexpr int IA = (DM / 64) * (INA / 32), IB = (DM / 64) * (INB / 32), IO = (BRW / 64) * (DM / 32), IM = (DM / 64) * (DM / 32);
        constexpr int NITEMS = IA + IB + 2 * IO + 2 * IM;
        for (int it = gw; it < NITEMS; it += NGW) {
            int r = it;
            if (r < IA) { transpose_item<1>(KARG(w_in_a), DM, INA, Wa_t, 0, KARG(norm_g), scr, r, lane); continue; } r -= IA;
            if (r < IB) { transpose_item<2>(KARG(w_in_b), DM, INB, Wb_t, 0, KARG(norm_g) + DM, scr, r, lane); continue; } r -= IB;
            if (r < IO) { transpose_item<0>(KARG(w_out), BRW, DM, Wo_t, 0, nullptr, scr, r, lane); continue; } r -= IO;
            if (r < IO) { transpose_item<0>(KARG(w_out) + (size_t)BRW * DM, BRW, DM, Wo_t + (size_t)DM * BRW, 0, nullptr, scr, r, lane); continue; } r -= IO;
            if (r < IM) { transpose_item<0>(KARG(w_mem_kv), DM, DM, Wm_t, 0, KARG(mem_norm_g), scr, r, lane); continue; } r -= IM;
            transpose_item<0>(KARG(w_mem_kv) + (size_t)DM * DM, DM, DM, Wm_t, DM, KARG(mem_norm_g) + DM, scr, r, lane);
        }
        {
            const float* xin = KARG(x); const float* min_ = KARG(mem);
            for (int m0 = gw; m0 < NTOK + BATCH * NMEM; m0 += 4 * NGW) {
                f32x4 v[4][4]; float ss_[4];
#pragma unroll
                for (int q = 0; q < 4; ++q) { const int m = m0 + q * NGW; ss_[q] = 0.f;
                    if (m < NTOK + BATCH * NMEM) { const f32x4* xr = (const f32x4*)(m < NTOK ? xin + (size_t)m * DM : min_ + (size_t)(m - NTOK) * DM) + lane;
#pragma unroll
                        for (int j = 0; j < 4; ++j) v[q][j] = xr[64 * j]; } }
#pragma unroll
                for (int q = 0; q < 4; ++q) { const int m = m0 + q * NGW;
                    if (m < NTOK + BATCH * NMEM) {
#pragma unroll
                        for (int j = 0; j < 4; ++j) ss_[q] += (v[q][j].x * v[q][j].x + v[q][j].y * v[q][j].y) + (v[q][j].z * v[q][j].z + v[q][j].w * v[q][j].w);
                        const float rstd = rsqrtf(wave_sum(ss_[q], lane) * (1.f / DM) + EPS);
                        bf16_t* orow = (m < NTOK) ? A0 + (size_t)(m / CTOK) * ((size_t)CTOK * BRW) + (size_t)(m % CTOK) * DM : memA + (size_t)(m - NTOK) * DM;
                        unsigned long long* o8 = (unsigned long long*)orow + lane;
#pragma unroll
                        for (int j = 0; j < 4; ++j) o8[64 * j] = (unsigned long long)pk2(v[q][j].x * rstd, v[q][j].y * rstd) | ((unsigned long long)pk2(v[q][j].z * rstd, v[q][j].w * rstd) << 32); } }
            }
        }
        for (int idx = bx * 512 + t0; idx < SEQ * 80; idx += G * 512) {
            const int t = idx / 80, i = idx % 80;
            if (i < 16) tabA[t * 16 + i] = cos_sin((double)t, 13.122363377404328  , (double)i / 16.0);
            else { const int k = i - 16, f = k & 31; tabB[t * 64 + k] = cos_sin((double)(k < 32 ? (t >> 6) : (t & 63)), 9.210340371976184  , (double)f / 32.0); }
        }
    }
#endif
    grid.sync();

#ifndef SKIP_PM
    {
        PHASE_PTRS();
        pg8::Gemm g2{launder(memA), launder(Wm_t), BATCH * NMEM, 2 * DM, DM}; pg8::StaticOrder S2; S2.init(BATCH * NMEM, 2 * DM, G, bx);
        EpiHead<1> E2{launder(MKV), nullptr, launder(KARG(mem_kn_g)), nullptr, nullptr, nullptr};
        pg8::gemm_phase(wave, lds3, g2, S2, E2);
    }
#endif
#pragma unroll 1
    for (int ch = 0; ch < NCH; ++ch) {
#ifndef SKIP_P1
#pragma unroll 1
        for (int rep = 0; rep < REP_P1; ++rep) {
            PHASE_PTRS();
            pg8::Gemm g{launder(A0 + (size_t)ch * CTOK * BRW), launder(Wa_t), CTOK, INA, DM}; pg8::StaticOrder S; S.init(CTOK, INA, G, bx, P1_WGM);
            EpiHead<0> E{launder(R), launder(KARG(qn_a)), launder(KARG(kn_a)), launder(KARG(mem_qn_g)), nullptr, launder(tabA)};
            pg8::gemm_phase(wave, lds3, g, S, E);
        }
#endif
        GRID_BAR();
#ifndef SKIP_P2
        {
            PHASE_PTRS();
            const bf16_t* QKV = launder(R + R_QKV / 2); const bf16_t* GATE = launder(R + R_GATE0 / 2); const bf16_t* QM = launder(R + R_QM0 / 2);
#ifdef PROBE_P2
#pragma unroll 1
            for (int rep2 = 0; rep2 < 2; ++rep2)
#endif
#pragma unroll 1
            for (int u = bx; u < 1536; u += G) {
                {
                    int bl, gg, h, qb;
                    if (u < 1024) { qb = u & 15; h = (u >> 4) & 7; gg = (u >> 7) & 1; bl = u >> 8; }
                    else { const int v = u - 1024; qb = v & 15; h = (v >> 4) & 7; bl = v >> 7; gg = 2; }
                    const int dl = 2 * gg, L = SEQ >> dl, i0g = qb * 256, res = i0g / L, i0 = i0g % L, NT = (L == 256) ? 4 : 6;
                    int ks = i0 - 64; if (ks < 0) ks = 0; if (ks > L - 64 * NT) ks = L - 64 * NT;
                    const size_t hb = (size_t)((bl * 3 + 0) * 3 + gg) * 8 + h;
                    const int dd = 1 << dl;
                    const bf16_t* Qp = QKV + (hb * 4096 + res + (size_t)i0 * dd) * 128;
                    const bf16_t* Kp = QKV + ((hb + 24) * 4096 + res + (size_t)ks * dd) * 128;
                    const bf16_t* Vp = QKV + ((hb + 48) * 4096 + res + (size_t)ks * dd) * 128;
                    att::EpiDil E{(bf16_t*)Qp, LSE + ((size_t)((bl * 3 + gg) * 8 + h)) * 4096 + res + i0 * dd, 128 * dd};
#ifdef PROBE_P2
                    if (rep2) { E.O = (bf16_t*)(dob + 96 * MiB); E.lse = (float*)(dob + 97 * MiB); }
#endif
                    att::attn_unit<true>(tid_now(wave), Qp, Kp, Vp, NT, ks - i0, (char*)lds, E, 128 * dd);
                }
            }
#pragma unroll 1
            for (int u = 1536 + bx; u < 1792; u += G) {
                {
                    const int v = u - 1536, qb = v & 15, mh = (v >> 4) & 3, bl = v >> 6, b = ch * CB + bl;
                    const bf16_t* Qp = QM + ((size_t)(bl * 4 + mh) * 4096 + qb * 256) * 128;
                    const bf16_t* Kp = MKV + (size_t)(((0 * 2 + 0) * 8 + b) * 4 + mh) * 256 * 128;
                    const bf16_t* Vp = MKV + (size_t)(((0 * 2 + 1) * 8 + b) * 4 + mh) * 256 * 128;
                    const size_t tl = (size_t)bl * 4096 + qb * 256;
                    att::EpiGate E{Y + ((size_t)ch * CTOK + tl) * BRW + 1024 + mh * 128, GATE + tl * BRW + 1024 + mh * 128};
                    att::attn_unit<false>(tid_now(wave), Qp, Kp, Vp, 4, 0, (char*)lds, E);
                }
            }
        }
#endif
        GRID_BAR();
#ifndef SKIP_P3
#pragma unroll 1
        for (int rep = 0; rep < REP_P3; ++rep) {
            PHASE_PTRS();
            const bf16_t* QKV = launder(R + R_QKV / 2); const bf16_t* GATE = launder(R + R_GATE0 / 2);
            const int t3 = tid_now(wave);
            for (int it = bx * 512 + t3; it < CTOK * 128; it += G * 512) {
                const int c = it & 15, h = (it >> 4) & 7, tl = it >> 7, bl = tl >> 12, t = tl & 4095;
                float ls[3]; bf16x8 ov[3];
#pragma unroll
                for (int gg = 0; gg < 3; ++gg) { const int p = t;
                    const size_t hb = (size_t)((bl * 3 + 0) * 3 + gg) * 8 + h;
                    ls[gg] = LSE[((size_t)((bl * 3 + gg) * 8 + h)) * 4096 + p];
                    ov[gg] = *(const bf16x8*)(QKV + (hb * 4096 + p) * 128 + c * 8); }
                const float mx = fmaxf(ls[0], fmaxf(ls[1], ls[2]));
                float w0 = __expf(ls[0] - mx), w1 = __expf(ls[1] - mx), w2 = __expf(ls[2] - mx); const float inv = 1.f / (w0 + w1 + w2); w0 *= inv; w1 *= inv; w2 *= inv;
                const bf16x8 gv = *(const bf16x8*)(GATE + (size_t)tl * BRW + h * 128 + c * 8);
                float r[8];
#pragma unroll
                for (int e = 0; e < 8; ++e) { const float o = w0 * bf2f((unsigned short)ov[0][e]) + w1 * bf2f((unsigned short)ov[1][e]) + w2 * bf2f((unsigned short)ov[2][e]);
                    r[e] = o * silu(bf2f((unsigned short)gv[e])); }
                u32x4 w; w.x = pk2(r[0], r[1]); w.y = pk2(r[2], r[3]); w.z = pk2(r[4], r[5]); w.w = pk2(r[6], r[7]);
                *(u32x4*)(Y + ((size_t)ch * CTOK + tl) * BRW + h * 128 + c * 8) = w;
            }
        }
#endif
        GRID_BAR();
    }

#ifndef SKIP_P4
#pragma unroll 1
    for (int rep = 0; rep < REP_P4; ++rep) {
        PHASE_PTRS();
        pg8::Gemm g{launder(Y), launder(Wo_t), NTOK, DM, BRW}; pg8::StaticOrder S; S.init(NTOK, DM, G, bx);
        EpiRes<true> E{launder(KARG(x)), launder(KARG(out)), launder(R + R_A1 / 2), launder(SS1)};
        pg8::gemm_phase(wave, lds3, g, S, E);
    }
#endif
    GRID_BAR();
#ifndef SKIP_P5
#pragma unroll 1
    for (int rep = 0; rep < REP_P5; ++rep) {
        PHASE_PTRS();
        pg8::Gemm g{launder(R + R_A1 / 2), launder(Wb_t), NTOK, INB, DM}; pg8::StaticOrder S; S.init(NTOK, INB, G, bx);
        EpiHead<2> E{launder(R), launder(KARG(qn_b)), launder(KARG(kn_b)), launder(KARG(mem_qn_g) + HD), launder(SS1), launder(tabB)};
        pg8::gemm_phase(wave, lds3, g, S, E);
    }
#endif
    GRID_BAR();
#ifndef SKIP_P6
#pragma unroll 1
    for (int rep = 0; rep < REP_P6; ++rep) {
        PHASE_PTRS();
        const bf16_t* Q1 = launder(R + R_Q1 / 2); const bf16_t* K1 = launder(R + R_K1 / 2); const bf16_t* V1 = launder(R + R_V1 / 2); const bf16_t* QM1 = launder(R + R_QM1 / 2); const bf16_t* GATE1 = launder(R + R_GATE1 / 2);
#pragma unroll 1
        for (int u = bx; u < 1024; u += G) {
            {
                int qb = u & 15, h = (u >> 4) & 7, b = u >> 7;
                if (G == 256) {
                    const int x = bx & 7, j = bx >> 3, r = u >> 8, pair = x + 8 * (r >> 1), idx = (r & 1) * 32 + j;
                    b = pair >> 1; h = (pair & 1) * 4 + (idx >> 4); qb = idx & 15; }
                const bf16_t* Qp = Q1 + ((size_t)(b * 8 + h) * 4096 + qb * 256) * 128;
                const bf16_t* Kp = K1 + (size_t)(b * 2 + (h >> 2)) * 4096 * 128;
                const bf16_t* Vp = V1 + (size_t)(b * 2 + (h >> 2)) * 4096 * 128;
                const size_t tl = (size_t)b * 4096 + qb * 256;
                att::EpiGate E{Y + tl * BRW + h * 128, GATE1 + tl * BRW + h * 128};
                att::attn_unit<false>(tid_now(wave), Qp, Kp, Vp, 64, 0, (char*)lds, E);
            }
        }
#pragma unroll 1
        for (int u = 1024 + bx; u < 1536; u += G) {
            {
                const int v = u - 1024, qb = v & 15, mh = (v >> 4) & 3, b = v >> 6;
                const bf16_t* Qp = QM1 + ((size_t)(b * 4 + mh) * 4096 + qb * 256) * 128;
                const bf16_t* Kp = MKV + (size_t)(((1 * 2 + 0) * 8 + b) * 4 + mh) * 256 * 128;
                const bf16_t* Vp = MKV + (size_t)(((1 * 2 + 1) * 8 + b) * 4 + mh) * 256 * 128;
                const size_t tl = (size_t)b * 4096 + qb * 256;
                att::EpiGate E{Y + tl * BRW + 1024 + mh * 128, GATE1 + tl * BRW + 1024 + mh * 128};
                att::attn_unit<false>(tid_now(wave), Qp, Kp, Vp, 4, 0, (char*)lds, E);
            }
        }
    }
#endif
    GRID_BAR();
#ifndef SKIP_P7
    {
        PHASE_PTRS();
        pg8::Gemm g{launder(Y), launder(Wo_t + (size_t)DM * BRW), NTOK, DM, BRW}; pg8::StaticOrder S; S.init(NTOK, DM, G, bx);
        EpiRes<false> E{launder(KARG(out)), launder(KARG(out)), nullptr, nullptr};
        pg8::gemm_phase(wave, lds3, g, S, E);
    }
#endif
#ifdef PROBE_SYNC
#pragma unroll 1
    for (int i = 0; i < PROBE_SYNC; ++i) GRID_BAR();
#endif
#ifdef PROBE_GEMM
    GRID_BAR();
    {
        PHASE_PTRS();
        pg8::Gemm g{launder(Y), launder(Wb_t), NTOK, INB, DM}; pg8::StaticOrder S; S.init(NTOK, INB, G, bx);
        EpiPlain E{launder(R), INB};
        pg8::gemm_phase(wave, lds3, g, S, E);
    }
#endif
}

extern "C" void kernel_launch(void* const* d_in, const int* in_sizes, int n_in, void* d_out, int out_size, void* d_ws, size_t ws_size, hipStream_t stream) {
    static int grid = 0;
    if (grid == 0) {
        if (n_in != 14 || out_size != NTOK * DM || ws_size < WS_END2) { fprintf(stderr, "kernel_launch: unexpected shapes (n_in %d out %d ws %zu)\n", n_in, out_size, ws_size); grid = -1; return; }
        int dev = 0, cus = 0, per_cu = 0;
        if (hipGetDevice(&dev) != hipSuccess || hipDeviceGetAttribute(&cus, hipDeviceAttributeMultiprocessorCount, dev) != hipSuccess) { grid = -1; return; }
        if (hipFuncSetAttribute((const void*)mega_fwd, hipFuncAttributeMaxDynamicSharedMemorySize, LDS_BYTES) != hipSuccess) { fprintf(stderr, "kernel_launch: hipFuncSetAttribute failed\n"); grid = -1; return; }
        if (hipOccupancyMaxActiveBlocksPerMultiprocessor(&per_cu, (const void*)mega_fwd, 512, LDS_BYTES) != hipSuccess || per_cu < 1) { fprintf(stderr, "kernel_launch: occupancy query says %d\n", per_cu); grid = -1; return; }
        grid = cus;
    }
    if (grid < 0) return;
    if (hipMemsetAsync((char*)d_ws + WS_BAR, 0, XCD_BAR_WORDS * 4, stream) != hipSuccess) { fprintf(stderr, "kernel_launch: memset failed\n"); return; }
    Params p{};
    p.x = (const float*)d_in[0]; p.mem = (const float*)d_in[1]; p.norm_g = (const float*)d_in[2]; p.mem_norm_g = (const float*)d_in[3];
    p.w_mem_kv = (const float*)d_in[4]; p.mem_qn_g = (const float*)d_in[5]; p.mem_kn_g = (const float*)d_in[6]; p.w_out = (const float*)d_in[7];
    p.w_in_a = (const float*)d_in[8]; p.qn_a = (const float*)d_in[9]; p.kn_a = (const float*)d_in[10]; p.w_in_b = (const float*)d_in[11];
    p.qn_b = (const float*)d_in[12]; p.kn_b = (const float*)d_in[13]; p.out = (float*)d_out; p.ws = (unsigned char*)d_ws;
    void* args[] = {&p};
    hipError_t e = hipLaunchCooperativeKernel((const void*)mega_fwd, dim3(grid), dim3(512), args, LDS_BYTES, stream);
    if (e != hipSuccess) fprintf(stderr, "cooperative launch failed: %s (grid %d)\n", hipGetErrorString(e), grid);
}
```
